# Optimizing an MI355X kernel written in HIP

```python
import math
import jax, jax.numpy as jnp
from jax import lax
import numpy as np

D_MODEL = 1024
BATCH = 32
SEQ = 2048
DEPTH = 2

ROPE_THETA = 500000.0
ROPE_FRACTION = 4
NORM_EPS = 1e-6
Q_BLOCK = 128

H_A = 4
DH_A = 64
H_B = 4
DK_B = 128
DV_B = 128
CONV_B = 4
CHUNK_B = 64
H_C = 8
Q_LORA_C = 256
KV_LORA_C = 128
NOPE_C = 64
ROPE_C = 32
V_C = 64
H_D = 8
DH_D = 64
DIL_GROUPS = ((128, 1), (512, 4), (2048, 16))
N_DIL = 3
D_BLOCK = 128

N_BRANCH = 4
BRANCH_W = 512
DEEPNORM_ALPHA = (2.0 * DEPTH) ** 0.25
DEEPNORM_BETA = (8.0 * DEPTH) ** -0.25

IN_SPLITS = (
    H_A * 2 * DH_A, H_A * 2 * DH_A, H_A * 2 * DH_A,
    H_B * DK_B, H_B * DK_B, H_B * DV_B, H_B, H_B,
    Q_LORA_C, KV_LORA_C, ROPE_C,
    3 * N_DIL * H_D * DH_D,
    N_BRANCH * BRANCH_W,
    N_BRANCH * D_MODEL,
)
D_IN = sum(IN_SPLITS)

kernel_name = 'hybrid_gated_diff_delta_mla_dilated'


def _layernorm(x):
    xf = x.astype(jnp.float32)
    mu = jnp.mean(xf, -1, keepdims=True)
    var = jnp.mean(jnp.square(xf - mu), -1, keepdims=True)
    return ((xf - mu) * lax.rsqrt(var + NORM_EPS)).astype(x.dtype)


def _rmsnorm(x, g):
    xf = x.astype(jnp.float32)
    y = xf * lax.rsqrt(jnp.mean(jnp.square(xf), -1, keepdims=True) + NORM_EPS)
    return (y * g.astype(jnp.float32)).astype(x.dtype)


def _l2norm(x):
    xf = x.astype(jnp.float32)
    return (xf * lax.rsqrt(jnp.sum(jnp.square(xf), -1, keepdims=True) + NORM_EPS)).astype(x.dtype)


def _rope(x, pos, rot_dim):
    half = rot_dim // 2
    inv_freq = ROPE_THETA ** (-jnp.arange(half, dtype=jnp.float32) / half)
    ang = pos.astype(jnp.float32)[..., None] * inv_freq
    cos = jnp.cos(ang)[:, :, None, :]
    sin = jnp.sin(ang)[:, :, None, :]
    xr = x[..., :rot_dim].astype(jnp.float32)
    x1, x2 = xr[..., :half], xr[..., half:]
    rot = jnp.concatenate([x1 * cos - x2 * sin, x2 * cos + x1 * sin], -1).astype(x.dtype)
    return jnp.concatenate([rot, x[..., rot_dim:]], -1)


def _causal_block_sweep(attend, seq):
    return jnp.concatenate([attend(s, s + Q_BLOCK) for s in range(0, seq, Q_BLOCK)], axis=1)


def _causal_mask(s, e):
    return jnp.arange(s, e)[:, None] >= jnp.arange(e)[None, :]


def _diff_attention(q, k, v, lam, pos):
    B, S = q.shape[:2]
    rot = DH_A // ROPE_FRACTION
    q = _rope(q.reshape(B, S, H_A * 2, DH_A), pos, rot).reshape(B, S, H_A, 2, DH_A)
    k = _rope(k.reshape(B, S, H_A * 2, DH_A), pos, rot).reshape(B, S, H_A, 2, DH_A)
    scale = DH_A ** -0.5

    def attend(s, e):
        sc = jnp.einsum('bqhmd,bkhmd->bhmqk', q[:, s:e], k[:, :e]).astype(jnp.float32) * scale
        sc = jnp.where(_causal_mask(s, e), sc, -jnp.inf)
        p = jax.nn.softmax(sc, axis=-1)
        p = p[:, :, 0] - lam * p[:, :, 1]
        return jnp.einsum('bhqk,bkhd->bqhd', p.astype(v.dtype), v[:, :e])

    return _causal_block_sweep(attend, S)


def _short_conv(x, w):
    S = x.shape[1]
    xp = jnp.pad(x, ((0, 0), (CONV_B - 1, 0), (0, 0)))
    return sum(xp[:, j:j + S] * w[j] for j in range(CONV_B))


def _gated_delta_rule(q, k, v, g, beta):
    B, S, H, dk = q.shape
    dv = v.shape[-1]
    C = CHUNK_B
    N = S // C
    f32 = jnp.float32

    def chunks(t):
        return t.astype(f32).reshape(B, N, C, H, -1).transpose(0, 3, 1, 2, 4)

    qc = chunks(q) * (dk ** -0.5)
    kc = chunks(k)
    vc = chunks(v)
    bc = beta.astype(f32).reshape(B, N, C, H).transpose(0, 3, 1, 2)
    gc = jnp.cumsum(g.astype(f32).reshape(B, N, C, H).transpose(0, 3, 1, 2), axis=-1)
    tril = jnp.tril(jnp.ones((C, C), bool))
    strict = jnp.tril(jnp.ones((C, C), bool), -1)
    diff = gc[..., :, None] - gc[..., None, :]
    decay = jnp.where(tril, jnp.exp(jnp.where(tril, diff, 0.0)), 0.0)
    k_beta = kc * bc[..., None]
    lower = jnp.where(strict, jnp.einsum('bhncd,bhnmd->bhncm', k_beta, kc) * decay, 0.0)
    a_mat = jnp.eye(C, dtype=f32) + lower
    rhs = jnp.concatenate([vc * bc[..., None], k_beta * jnp.exp(gc)[..., None]], -1)
    sol = lax.linalg.triangular_solve(a_mat, rhs, left_side=True, lower=True, unit_diagonal=True)
    u, w = sol[..., :dv], sol[..., dv:]
    qk = jnp.where(tril, jnp.einsum('bhncd,bhnmd->bhncm', qc, kc) * decay, 0.0)

    def step(state, xs):
        q_i, k_i, u_i, w_i, qk_i, g_i = xs
        v_new = u_i - jnp.einsum('bhcd,bhde->bhce', w_i, state)
        o = (jnp.einsum('bhcd,bhde->bhce', q_i * jnp.exp(g_i)[..., None], state)
             + jnp.einsum('bhcm,bhme->bhce', qk_i, v_new))
        g_last = g_i[..., -1]
        state = (state * jnp.exp(g_last)[..., None, None]
                 + jnp.einsum('bhcd,bhce->bhde', k_i * jnp.exp(g_last[..., None] - g_i)[..., None], v_new))
        return state, o

    xs = tuple(jnp.moveaxis(t, 2, 0) for t in (qc, kc, u, w, qk, gc))
    state0 = jnp.zeros((B, H, dk, dv), f32)
    _, o = lax.scan(step, state0, xs)
    return o.transpose(1, 0, 3, 2, 4).reshape(B, S, H, dv).astype(v.dtype)


def _mla(c_q, c_kv, k_pe, q_norm_c, w_uq, kv_norm_c, w_ukv, pos):
    B, S = c_q.shape[:2]
    q = (_rmsnorm(c_q, q_norm_c) @ w_uq).reshape(B, S, H_C, NOPE_C + ROPE_C)
    kv = (_rmsnorm(c_kv, kv_norm_c) @ w_ukv).reshape(B, S, H_C, NOPE_C + V_C)
    q_nope, q_pe = q[..., :NOPE_C], _rope(q[..., NOPE_C:], pos, ROPE_C)
    k_nope, v = kv[..., :NOPE_C], kv[..., NOPE_C:]
    k_pe = _rope(k_pe[:, :, None, :], pos, ROPE_C)[:, :, 0]
    scale = (NOPE_C + ROPE_C) ** -0.5

    def attend(s, e):
        sc = (jnp.einsum('bqhd,bkhd->bhqk', q_nope[:, s:e], k_nope[:, :e])
              + jnp.einsum('bqhd,bkd->bhqk', q_pe[:, s:e], k_pe[:, :e])).astype(jnp.float32) * scale
        sc = jnp.where(_causal_mask(s, e), sc, -jnp.inf)
        p = jax.nn.softmax(sc, axis=-1)
        return jnp.einsum('bhqk,bkhd->bqhd', p.astype(v.dtype), v[:, :e])

    return _causal_block_sweep(attend, S)


def _dilated_group(q, k, v, dilation, steps):
    B, S, H, dh = q.shape
    L = S // dilation
    nb = -(-L // D_BLOCK)
    Lp = nb * D_BLOCK

    def sub(t):
        t = t.reshape(B, L, dilation, H, dh).transpose(0, 2, 1, 3, 4)
        t = jnp.pad(t, ((0, 0), (0, 0), (0, Lp - L), (0, 0), (0, 0)))
        return t.reshape(B, dilation, nb, D_BLOCK, H, dh)

    def with_prev(t):
        prev = jnp.pad(t, ((0, 0), (0, 0), (1, 0), (0, 0), (0, 0), (0, 0)))[:, :, :-1]
        return jnp.concatenate([prev, t], axis=3)

    qs, kk, vv = sub(q), with_prev(sub(k)), with_prev(sub(v))
    a = jnp.arange(D_BLOCK)[:, None]
    b = jnp.arange(2 * D_BLOCK)[None, :]
    rel = D_BLOCK + a - b
    blk = jnp.arange(nb)[:, None, None]
    valid = (rel >= 0) & (rel <= steps) & ((blk > 0) | (b >= D_BLOCK))
    sc = jnp.einsum('bdnqhe,bdnkhe->bdnhqk', qs, kk).astype(jnp.float32) * (dh ** -0.5)
    sc = jnp.where(valid[:, None], sc, -jnp.inf)
    lse = jax.nn.logsumexp(sc, axis=-1)
    p = jnp.exp(sc - lse[..., None])
    o = jnp.einsum('bdnhqk,bdnkhe->bdnqhe', p.astype(vv.dtype), vv)

    def unsub(t):
        t = t.reshape(B, dilation, Lp, *t.shape[4:])[:, :, :L]
        return t.swapaxes(1, 2).reshape(B, S, *t.shape[3:])

    return unsub(o), unsub(jnp.swapaxes(lse, -1, -2)[..., None])[..., 0]


def _dilated_attention(q, k, v, pos):
    rot = DH_D // ROPE_FRACTION
    outs, lses = [], []
    for gi, (window, dil) in enumerate(DIL_GROUPS):
        o, l = _dilated_group(_rope(q[:, :, gi], pos, rot), _rope(k[:, :, gi], pos, rot),
                              v[:, :, gi], dil, window // dil)
        outs.append(o)
        lses.append(l)
    wts = jax.nn.softmax(jnp.stack(lses, -1), axis=-1)
    return jnp.einsum('bshg,gbshe->bshe', wts.astype(outs[0].dtype), jnp.stack(outs, 0))


def _mixer_sublayer(h, pos, layer, w_in, conv_b, a_log, dt_bias, out_norm_b,
                    lambda_q1, lambda_k1, lambda_q2, lambda_k2, subln_g,
                    q_norm_c, w_uq, kv_norm_c, w_ukv, w_br, w_out):
    B, S, _ = h.shape
    f32 = jnp.float32
    offsets = [int(o) for o in np.cumsum(IN_SPLITS)[:-1]]
    (q_a, k_a, v_a, q_b, k_b, v_b, beta_b, decay_b, cq_c, ckv_c, kpe_c,
     qkv_d, z, merge) = jnp.split(h @ w_in, offsets, axis=-1)

    lam_init = 0.8 - 0.6 * math.exp(-0.3 * layer)
    lam = (jnp.exp(jnp.sum(lambda_q1.astype(f32) * lambda_k1.astype(f32)))
           - jnp.exp(jnp.sum(lambda_q2.astype(f32) * lambda_k2.astype(f32))) + lam_init)
    o_a = _diff_attention(q_a.reshape(B, S, H_A, 2, DH_A), k_a.reshape(B, S, H_A, 2, DH_A),
                          v_a.reshape(B, S, H_A, 2 * DH_A), lam, pos)
    o_a = (_rmsnorm(o_a, subln_g) * (1.0 - lam_init)).reshape(B, S, BRANCH_W)

    qkv_b = jax.nn.silu(_short_conv(jnp.concatenate([q_b, k_b, v_b], -1), conv_b))
    q_b, k_b, v_b = jnp.split(qkv_b, [H_B * DK_B, 2 * H_B * DK_B], axis=-1)
    beta = jax.nn.sigmoid(beta_b.astype(f32))
    g = -jnp.exp(a_log.astype(f32)) * jax.nn.softplus(decay_b.astype(f32) + dt_bias.astype(f32))
    o_b = _gated_delta_rule(_l2norm(q_b.reshape(B, S, H_B, DK_B)), _l2norm(k_b.reshape(B, S, H_B, DK_B)),
                            v_b.reshape(B, S, H_B, DV_B), g, beta)
    o_b = _rmsnorm(o_b, out_norm_b).reshape(B, S, BRANCH_W)

    o_c = _mla(cq_c, ckv_c, kpe_c, q_norm_c, w_uq, kv_norm_c, w_ukv, pos).reshape(B, S, BRANCH_W)

    qkv_d = qkv_d.reshape(B, S, 3, N_DIL, H_D, DH_D)
    o_d = _dilated_attention(qkv_d[:, :, 0], qkv_d[:, :, 1], qkv_d[:, :, 2], pos).reshape(B, S, BRANCH_W)

    branches = jnp.stack([o_a, o_b, o_c, o_d], axis=2) * jax.nn.silu(z).reshape(B, S, N_BRANCH, BRANCH_W)
    gates = jax.nn.sigmoid(merge).reshape(B, S, N_BRANCH, D_MODEL)
    merged = jnp.einsum('bsnc,ncd,bsnd->bsd', branches, w_br, gates)
    return merged @ w_out


def setup_inputs(seed: int = 0) -> dict:
    key = jax.random.key(seed)
    ks = jax.random.split(key, 24)
    f32 = jnp.float32
    L = DEPTH

    def nrm(k, shape, scale):
        return jax.random.normal(k, shape, f32) * scale

    def gain(k, shape):
        return 1.0 + 0.02 * jax.random.normal(k, shape, f32)

    x = nrm(ks[0], (BATCH, SEQ, D_MODEL), 1.0)
    c = nrm(ks[1], (BATCH, D_MODEL), 1.0)
    offs = jax.random.randint(ks[2], (BATCH, 1), 0, 4096, dtype=jnp.int32)
    positions = offs + jnp.arange(SEQ, dtype=jnp.int32)[None, :]
    w_ada = nrm(ks[3], (L, D_MODEL, 3 * D_MODEL), D_MODEL ** -0.5)
    b_ada = nrm(ks[4], (L, 3 * D_MODEL), 0.02)
    w_in = nrm(ks[5], (L, D_MODEL, D_IN), D_MODEL ** -0.5)
    conv_b = nrm(ks[6], (L, CONV_B, 2 * H_B * DK_B + H_B * DV_B), CONV_B ** -0.5)
    a_log = jnp.log(jax.random.uniform(ks[7], (L, H_B), f32, 1.0, 16.0))
    dt = jnp.exp(jax.random.uniform(ks[8], (L, H_B), f32, math.log(1e-3), math.log(1e-1)))
    dt_bias = dt + jnp.log(-jnp.expm1(-dt))
    out_norm_b = gain(ks[9], (L, DV_B))
    lambda_q1 = nrm(ks[10], (L, DH_A), 0.1)
    lambda_k1 = nrm(ks[11], (L, DH_A), 0.1)
    lambda_q2 = nrm(ks[12], (L, DH_A), 0.1)
    lambda_k2 = nrm(ks[13], (L, DH_A), 0.1)
    subln_g = gain(ks[14], (L, 2 * DH_A))
    q_norm_c = gain(ks[15], (L, Q_LORA_C))
    w_uq = nrm(ks[16], (L, Q_LORA_C, H_C * (NOPE_C + ROPE_C)), Q_LORA_C ** -0.5)
    kv_norm_c = gain(ks[17], (L, KV_LORA_C))
    w_ukv = nrm(ks[18], (L, KV_LORA_C, H_C * (NOPE_C + V_C)), KV_LORA_C ** -0.5)
    w_br = nrm(ks[19], (L, N_BRANCH, BRANCH_W, D_MODEL), DEEPNORM_BETA * BRANCH_W ** -0.5)
    w_out = nrm(ks[20], (L, D_MODEL, D_MODEL), DEEPNORM_BETA * D_MODEL ** -0.5)
    ln_g = gain(ks[21], (L, D_MODEL))
    ln_b = nrm(ks[22], (L, D_MODEL), 0.02)
    return {'x': x, 'c': c, 'positions': positions, 'w_ada': w_ada, 'b_ada': b_ada,
            'w_in': w_in, 'conv_b': conv_b, 'a_log': a_log, 'dt_bias': dt_bias,
            'out_norm_b': out_norm_b, 'lambda_q1': lambda_q1, 'lambda_k1': lambda_k1,
            'lambda_q2': lambda_q2, 'lambda_k2': lambda_k2, 'subln_g': subln_g,
            'q_norm_c': q_norm_c, 'w_uq': w_uq, 'kv_norm_c': kv_norm_c, 'w_ukv': w_ukv,
            'w_br': w_br, 'w_out': w_out, 'ln_g': ln_g, 'ln_b': ln_b}


def reference(x, c, positions, w_ada, b_ada, w_in, conv_b, a_log, dt_bias, out_norm_b,
              lambda_q1, lambda_k1, lambda_q2, lambda_k2, subln_g, q_norm_c, w_uq,
              kv_norm_c, w_ukv, w_br, w_out, ln_g, ln_b):
    c_act = jax.nn.silu(c)
    for l in range(DEPTH):
        shift, scale, gate = jnp.split(c_act @ w_ada[l] + b_ada[l], 3, axis=-1)
        h = _layernorm(x) * (1.0 + scale[:, None, :]) + shift[:, None, :]
        y = _mixer_sublayer(h, positions, l, w_in[l], conv_b[l], a_log[l], dt_bias[l], out_norm_b[l],
                            lambda_q1[l], lambda_k1[l], lambda_q2[l], lambda_k2[l], subln_g[l],
                            q_norm_c[l], w_uq[l], kv_norm_c[l], w_ukv[l], w_br[l], w_out[l])
        x = _layernorm(DEEPNORM_ALPHA * x + gate[:, None, :] * y) * ln_g[l] + ln_b[l]
    return x
```

```cpp
#include <hip/hip_runtime.h>
#include <hip/hip_cooperative_groups.h>
#include <cstdio>
#include <cstdint>
namespace cg = cooperative_groups;

#ifndef MULTI_LAUNCH
#define MULTI_LAUNCH 0
#endif

typedef unsigned short bf16_t;
typedef short bf16x8 __attribute__((ext_vector_type(8)));
typedef float f32x4 __attribute__((ext_vector_type(4)));
typedef unsigned u32x4 __attribute__((ext_vector_type(4)));
typedef unsigned u32x2 __attribute__((ext_vector_type(2)));

#define DEVI __device__ __forceinline__

constexpr int S_ = 2048, DM = 1024, NBT = 32, NB = 8, NGRP = 4, TG = NB * S_;
constexpr int LDY = 14336;
constexpr int LDH = 1024 + 64, LDW = 1024 + 64;
constexpr int YA_Q = 0, YA_K = 512, YB_Q = 1536, YC = 3072, YKPE = 3456, YBETA = 3488, YDECAY = 3492,
              YD_Q = 3584, YD_K = 5120, YZ = 8192, YMG = 10240;
constexpr float EPS = 1e-6f;
constexpr float LOG2E = 1.4426950408889634f, LN2 = 0.6931471805599453f;
constexpr int SMEM_BYTES = 74240;
constexpr int NPHASE = 2 + NGRP * 2 * 6;

struct P {
  const float *x, *c; const int* pos;
  const float *w_ada, *b_ada, *w_in, *conv_b, *a_log, *dt_bias, *out_norm_b, *lq1, *lk1, *lq2, *lk2, *subln_g,
      *q_norm_c, *w_uq, *kv_norm_c, *w_ukv, *w_br, *w_out, *ln_g, *ln_b;
  float* out;
  char* ws;
  DEVI bf16_t* f_wInT() const { return (bf16_t*)(ws + 0ULL); }
  DEVI bf16_t* f_wUqT() const { return (bf16_t*)(ws + 62390272ULL); }
  DEVI bf16_t* f_wUkvT() const { return (bf16_t*)(ws + 63176704ULL); }
  DEVI bf16_t* f_wBrT() const { return (bf16_t*)(ws + 63700992ULL); }
  DEVI bf16_t* f_wOutT() const { return (bf16_t*)(ws + 72089600ULL); }
  DEVI float* f_mod() const { return (float*)(ws + 76283904ULL); }
  DEVI float2* f_ropeA() const { return (float2*)(ws + 77070336ULL); }
  DEVI float2* f_ropeC() const { return (float2*)(ws + 81264640ULL); }
  DEVI float* f_lam() const { return (float*)(ws + 89653248ULL); }
  DEVI int* f_ctr() const { return (int*)(ws + 89653504ULL); }
  DEVI int* f_ctr2() const { return (int*)(ws + 89654528ULL); }
  DEVI unsigned* f_bar() const { return (unsigned*)(ws + 89655552ULL); }
  DEVI bf16_t* f_h() const { return (bf16_t*)(ws + 89669376ULL); }
  DEVI bf16_t* f_Y() const { return (bf16_t*)(ws + 232275712ULL); }
  DEVI bf16_t* f_AvT() const { return (bf16_t*)(ws + 702037760ULL); }
  DEVI bf16_t* f_DvT() const { return (bf16_t*)(ws + 718814976ULL); }
  DEVI bf16_t* f_Qc() const { return (bf16_t*)(ws + 769146624ULL); }
  DEVI bf16_t* f_Kc() const { return (bf16_t*)(ws + 794312448ULL); }
  DEVI bf16_t* f_CvT() const { return (bf16_t*)(ws + 819478272ULL); }
  DEVI bf16_t* f_Do() const { return (bf16_t*)(ws + 836255488ULL); }
  DEVI float* f_Dlse() const { return (float*)(ws + 886587136ULL); }
  DEVI bf16_t* f_UT() const { return (bf16_t*)(ws + 888160000ULL); }
  DEVI bf16_t* f_Wm() const { return (bf16_t*)(ws + 904937216ULL); }
  DEVI bf16_t* f_QG() const { return (bf16_t*)(ws + 921714432ULL); }
  DEVI bf16_t* f_KGT() const { return (bf16_t*)(ws + 938491648ULL); }
  DEVI bf16_t* f_QKm() const { return (bf16_t*)(ws + 955268864ULL); }
  DEVI float* f_dlast() const { return (float*)(ws + 963657472ULL); }
  DEVI bf16_t* f_br() const { return (bf16_t*)(ws + 963661568ULL); }
  DEVI bf16_t* f_merged() const { return f_Do(); }
};
constexpr size_t WS_TOTAL = 1030770432ULL, WS_BAR_OFF = 89655552ULL;


DEVI int TID() { int t = threadIdx.x; asm volatile("" : "+v"(t)); return t; }
DEVI float bf2f(bf16_t b) { return __uint_as_float(((unsigned)b) << 16); }
DEVI bf16_t f2bf(float f) { unsigned u = __float_as_uint(f); u += 0x7fffu + ((u >> 16) & 1u); return (bf16_t)(u >> 16); }
typedef float f32x2_t __attribute__((ext_vector_type(2)));
typedef __bf16 bf16x2_t __attribute__((ext_vector_type(2)));
DEVI unsigned pk2(float lo, float hi) { f32x2_t v = {lo, hi}; bf16x2_t b = __builtin_convertvector(v, bf16x2_t); return __builtin_bit_cast(unsigned, b); }
DEVI float lo2f(unsigned u) { return __uint_as_float(u << 16); }
DEVI float hi2f(unsigned u) { return __uint_as_float(u & 0xffff0000u); }
DEVI f32x4 mma(bf16x8 a, bf16x8 b, f32x4 c) { return __builtin_amdgcn_mfma_f32_16x16x32_bf16(a, b, c, 0, 0, 0); }
DEVI float sigmf(float x) { return __builtin_amdgcn_rcpf(1.f + __builtin_amdgcn_exp2f(-1.4426950408889634f * x)); }
DEVI float siluf(float x) { return x * sigmf(x); }
DEVI float ex2(float x) { return __builtin_amdgcn_exp2f(x); }
DEVI bf16x8 ldfrag(const bf16_t* p) { return *(const bf16x8*)p; }

template <bool SWAP, int NT = 4>
DEVI void gemm_core(const bf16_t* __restrict__ A, long rs, const bf16_t* __restrict__ B, long ldb, int K,
                    f32x4 (&acc)[4][NT], bf16_t* sm) {
  const int tid = TID(), lane = tid & 63, wid = tid >> 6, g = lane >> 4, lr = lane & 15;
  const int wm = wid >> 1, wn = wid & 1;
  const int lrow = tid >> 3, lkc = (tid & 7) * 8;
  const int wsw = ((tid & 7) ^ ((lrow >> 1) & 7)) * 8;
  bf16_t* sA = sm; bf16_t* sB = sm + 2 * 128 * 64;
  const bf16_t* ap = A + (long)lrow * rs + lkc;
  const bf16_t* bp = B + (long)lrow * ldb + lkc;
  u32x4 ra0[4], rb0[NT], ra1[4], rb1[NT];
  const int nk = K >> 6;
#pragma unroll
  for (int i = 0; i < 4; ++i) ra0[i] = *(const u32x4*)(ap + (long)(32 * i) * rs);
#pragma unroll
  for (int i = 0; i < NT; ++i) rb0[i] = *(const u32x4*)(bp + (long)(32 * i) * ldb);
#pragma unroll
  for (int i = 0; i < 4; ++i) ra1[i] = *(const u32x4*)(ap + (long)(32 * i) * rs + 64);
#pragma unroll
  for (int i = 0; i < NT; ++i) rb1[i] = *(const u32x4*)(bp + (long)(32 * i) * ldb + 64);
#pragma unroll
  for (int i = 0; i < 4; ++i) *(u32x4*)&sA[(lrow + 32 * i) * 64 + wsw] = ra0[i];
#pragma unroll
  for (int i = 0; i < NT; ++i) *(u32x4*)&sB[(lrow + 32 * i) * 64 + wsw] = rb0[i];
  __syncthreads();
  const int f = (lr >> 1) & 7;
  const int rsw0 = (g ^ f) * 8, rsw1 = ((4 + g) ^ f) * 8;
  const bf16_t* cA0 = sA + (wm * 64 + lr) * 64;
  const bf16_t* cB0 = sB + (wn * NT * 16 + lr) * 64;
  auto compute = [&](int cur) {
    const bf16_t* cA = cA0 + cur * 128 * 64;
    const bf16_t* cB = cB0 + cur * 128 * 64;
#pragma unroll
    for (int ks = 0; ks < 2; ++ks) {
      const int rsw = ks ? rsw1 : rsw0;
      bf16x8 af[4];
#pragma unroll
      for (int t = 0; t < 4; ++t) af[t] = ldfrag(cA + t * 16 * 64 + rsw);
#pragma unroll
      for (int nt = 0; nt < NT; ++nt) {
        const bf16x8 bfr = ldfrag(cB + nt * 16 * 64 + rsw);
#pragma unroll
        for (int mt = 0; mt < 4; ++mt) {
          if (SWAP) acc[mt][nt] = mma(bfr, af[mt], acc[mt][nt]);
          else acc[mt][nt] = mma(af[mt], bfr, acc[mt][nt]);
        }
      }
    }
  };
  for (int kt = 0; kt < nk; kt += 2) {
    {
      const int kn = (kt + 2 < nk ? kt + 2 : nk - 1) * 64;
#pragma unroll
      for (int i = 0; i < 4; ++i) ra0[i] = *(const u32x4*)(ap + (long)(32 * i) * rs + kn);
#pragma unroll
      for (int i = 0; i < NT; ++i) rb0[i] = *(const u32x4*)(bp + (long)(32 * i) * ldb + kn);
    }
    compute(0);
    {
      bf16_t* nA = sA + 128 * 64; bf16_t* nB = sB + 128 * 64;
#pragma unroll
      for (int i = 0; i < 4; ++i) *(u32x4*)&nA[(lrow + 32 * i) * 64 + wsw] = ra1[i];
#pragma unroll
      for (int i = 0; i < NT; ++i) *(u32x4*)&nB[(lrow + 32 * i) * 64 + wsw] = rb1[i];
    }
    __syncthreads();
    {
      const int kn = (kt + 3 < nk ? kt + 3 : nk - 1) * 64;
#pragma unroll
      for (int i = 0; i < 4; ++i) ra1[i] = *(const u32x4*)(ap + (long)(32 * i) * rs + kn);
#pragma unroll
      for (int i = 0; i < NT; ++i) rb1[i] = *(const u32x4*)(bp + (long)(32 * i) * ldb + kn);
    }
    compute(1);
    if (kt + 2 < nk) {
#pragma unroll
      for (int i = 0; i < 4; ++i) *(u32x4*)&sA[(lrow + 32 * i) * 64 + wsw] = ra0[i];
#pragma unroll
      for (int i = 0; i < NT; ++i) *(u32x4*)&sB[(lrow + 32 * i) * 64 + wsw] = rb0[i];
    }
    __syncthreads();
  }
}

template <int NT>
DEVI void zero_acc(f32x4 (&acc)[4][NT]) {
#pragma unroll
  for (int i = 0; i < 4; ++i)
#pragma unroll
    for (int j = 0; j < NT; ++j) acc[i][j] = (f32x4){0.f, 0.f, 0.f, 0.f};
}

DEVI int src_col_win(int n) {
  if (n < 3072) return n;
  if (n < 3488) return 3080 + (n - 3072);
  if (n < 3496) return 3072 + (n - 3488);
  if (n < 3584) return -1;
  if (n < 8192) return 3496 + (n - 3584);
  if (n < 10240) return 8104 + (n - 8192);
  return 10152 + (n - 10240);
}

template <int MODE>
DEVI void tconv_tile(const float* __restrict__ src, int ldsrc, bf16_t* __restrict__ dst, int K, int n0, int k0,
                     const float* __restrict__ kscale, float* t) {
  const int tid = TID();
  const int kk = tid >> 4, nn = (tid & 15) * 4;
  const int n = n0 + nn;
  int sc;
  if (MODE == 0) sc = src_col_win(n);
  else if (MODE == 2) sc = (n < 512) ? ((n >> 6) * 128 + (n & 63)) : (((n - 512) >> 6) * 128 + 64 + ((n - 512) & 63));
  else sc = n;
#pragma unroll
  for (int i = 0; i < 4; ++i) {
    const int k = kk + 16 * i;
    float4 v = make_float4(0.f, 0.f, 0.f, 0.f);
    if (sc >= 0) v = *(const float4*)(src + (long)(k0 + k) * ldsrc + sc);
    if (kscale) { const float s = kscale[k0 + k]; v.x *= s; v.y *= s; v.z *= s; v.w *= s; }
    t[k * 65 + nn + 0] = v.x; t[k * 65 + nn + 1] = v.y; t[k * 65 + nn + 2] = v.z; t[k * 65 + nn + 3] = v.w;
  }
  __syncthreads();
  const int n2 = tid >> 2, kq = (tid & 3) * 16;
  u32x4 o0, o1;
  o0.x = pk2(t[(kq + 0) * 65 + n2], t[(kq + 1) * 65 + n2]); o0.y = pk2(t[(kq + 2) * 65 + n2], t[(kq + 3) * 65 + n2]);
  o0.z = pk2(t[(kq + 4) * 65 + n2], t[(kq + 5) * 65 + n2]); o0.w = pk2(t[(kq + 6) * 65 + n2], t[(kq + 7) * 65 + n2]);
  o1.x = pk2(t[(kq + 8) * 65 + n2], t[(kq + 9) * 65 + n2]); o1.y = pk2(t[(kq + 10) * 65 + n2], t[(kq + 11) * 65 + n2]);
  o1.z = pk2(t[(kq + 12) * 65 + n2], t[(kq + 13) * 65 + n2]); o1.w = pk2(t[(kq + 14) * 65 + n2], t[(kq + 15) * 65 + n2]);
  bf16_t* d = dst + (long)(n0 + n2) * K + k0 + kq;
  *(u32x4*)d = o0; *(u32x4*)(d + 8) = o1;
  __syncthreads();
}

DEVI void mod_item(const P& p, int item, char* smem) {
  const int l = item / 48, j0 = (item % 48) * 64;
  const int tid = TID(), kq = tid >> 6, j = tid & 63;
  float* cs = (float*)smem;
  float* red = cs + 4096;
  float acc[32];
#pragma unroll
  for (int b = 0; b < 32; ++b) acc[b] = 0.f;
  const float* w = p.w_ada + (long)l * 1024 * 3072 + j0 + j;
  for (int ch = 0; ch < 8; ++ch) {
#pragma unroll
    for (int i = 0; i < 16; ++i) {
      const int idx = tid + 256 * i;
      const int q = idx >> 10, b = (idx >> 5) & 31, kk = idx & 31;
      const float cv = p.c[b * 1024 + q * 256 + ch * 32 + kk];
      cs[idx] = siluf(cv);
    }
    __syncthreads();
#pragma unroll 1
    for (int kk4 = 0; kk4 < 8; ++kk4) {
      const int kb = kq * 256 + ch * 32 + kk4 * 4;
      const float w0 = w[(long)(kb + 0) * 3072], w1 = w[(long)(kb + 1) * 3072], w2 = w[(long)(kb + 2) * 3072], w3 = w[(long)(kb + 3) * 3072];
#pragma unroll
      for (int b = 0; b < 32; ++b) {
        const float4 cv = *(const float4*)&cs[(kq * 32 + b) * 32 + kk4 * 4];
        acc[b] += cv.x * w0 + cv.y * w1 + cv.z * w2 + cv.w * w3;
      }
    }
    __syncthreads();
  }
#pragma unroll
  for (int b = 0; b < 32; ++b) red[(kq * 32 + b) * 64 + j] = acc[b];
  __syncthreads();
#pragma unroll
  for (int i = 0; i < 8; ++i) {
    const int idx = tid + 256 * i;
    const int b = idx >> 6, jj = idx & 63;
    const float v = red[(0 * 32 + b) * 64 + jj] + red[(1 * 32 + b) * 64 + jj] + red[(2 * 32 + b) * 64 + jj] + red[(3 * 32 + b) * 64 + jj] +
                    p.b_ada[l * 3072 + j0 + jj];
    p.f_mod()[(long)(l * 32 + b) * 3072 + j0 + jj] = v;
  }
  __syncthreads();
}

DEVI void rope_item(const P& p, int item) {
  const int t = item * 256 + TID();
  const float pos = (float)p.pos[t];
  const double L2T = 18.931568569324174;
  const double INV2PI = 0.15915494309189535;
#pragma unroll
  for (int i = 0; i < 8; ++i) {
    const float invf = (float)exp2(-(double)i * L2T / 8.0);
    const float ang = pos * invf;
    const double rev = (double)ang * INV2PI;
    const float fr = (float)(rev - floor(rev));
    p.f_ropeA()[(long)t * 8 + i] = make_float2(__builtin_amdgcn_cosf(fr), __builtin_amdgcn_sinf(fr));
  }
#pragma unroll
  for (int i = 0; i < 16; ++i) {
    const float invf = (float)exp2(-(double)i * L2T / 16.0);
    const float ang = pos * invf;
    const double rev = (double)ang * INV2PI;
    const float fr = (float)(rev - floor(rev));
    p.f_ropeC()[(long)t * 16 + i] = make_float2(__builtin_amdgcn_cosf(fr), __builtin_amdgcn_sinf(fr));
  }
}

DEVI float wave_sum(float v) {
#pragma unroll
  for (int o = 32; o >= 1; o >>= 1) v += __shfl_xor(v, o);
  return v;
}

DEVI void ln_stats(const float4 (&v)[4], float& mu, float& rstd) {
  float s = 0.f;
#pragma unroll
  for (int i = 0; i < 4; ++i) s += (v[i].x + v[i].y) + (v[i].z + v[i].w);
  mu = wave_sum(s) * (1.f / 1024.f);
  float q = 0.f;
#pragma unroll
  for (int i = 0; i < 4; ++i) { const float a = v[i].x - mu, b = v[i].y - mu, c = v[i].z - mu, d = v[i].w - mu; q += (a * a + b * b) + (c * c + d * d); }
  rstd = rsqrtf(wave_sum(q) * (1.f / 1024.f) + EPS);
}

DEVI void store_h(const float4 (&v)[4], float mu, float rstd, const float* __restrict__ modb, bf16_t* __restrict__ hr, int lane) {
#pragma unroll
  for (int i = 0; i < 4; ++i) {
    const int col = i * 256 + lane * 4;
    const float4 sh = *(const float4*)(modb + col), sc = *(const float4*)(modb + 1024 + col);
    const float a = (v[i].x - mu) * rstd * (1.f + sc.x) + sh.x, b = (v[i].y - mu) * rstd * (1.f + sc.y) + sh.y;
    const float c = (v[i].z - mu) * rstd * (1.f + sc.z) + sh.z, d = (v[i].w - mu) * rstd * (1.f + sc.w) + sh.w;
    u32x2 o; o.x = pk2(a, b); o.y = pk2(c, d);
    *(u32x2*)(hr + col) = o;
  }
}

struct P1Tile { const bf16_t* A; long rs; const bf16_t* B; long tokbase; int bl, j, n0, gi, dl, res, ib; bool vt; };

DEVI void p1_desc(const P& p, int gg, int l, int mtile, int ntile, P1Tile& d) {
  d.bl = mtile >> 4; d.j = mtile & 15; d.n0 = ntile * 128;
  const bool segD = (d.n0 >= 3584 && d.n0 < 8192);
  d.dl = 1; d.gi = 0;
  if (segD) { d.gi = ((d.n0 - 3584) % 1536) / 512; d.dl = d.gi == 0 ? 1 : (d.gi == 1 ? 4 : 16); }
  const int nrb = 16 / d.dl;
  d.res = d.j / nrb; d.ib = d.j % nrb;
  d.tokbase = (long)gg * TG + d.bl * 2048;
  d.A = p.f_h() + (d.tokbase + (long)d.ib * 128 * d.dl + d.res) * LDH;
  d.rs = (long)d.dl * LDH;
  d.B = p.f_wInT() + ((long)l * LDY + d.n0) * LDW;
  d.vt = (d.n0 >= 1024 && d.n0 < 1536) || (d.n0 >= 6656 && d.n0 < 8192);
}

template <bool SWAP>
DEVI void gemm_stream(const bf16_t* __restrict__ ap, long rs, const bf16_t* __restrict__ bp,
                      const bf16_t* __restrict__ nap, long nrs, const bf16_t* __restrict__ nbp,
                      u32x4 (&ra0)[4], u32x4 (&rb0)[4], u32x4 (&ra1)[4], u32x4 (&rb1)[4], f32x4 (&acc)[4][4], bf16_t* sm) {
  const int tid = TID(), lane = tid & 63, wid = tid >> 6, g = lane >> 4, lr = lane & 15;
  const int wm = wid >> 1, wn = wid & 1;
  const int lrow = tid >> 3, lkc = (tid & 7) * 8;
  const int wsw = ((tid & 7) ^ ((lrow >> 1) & 7)) * 8;
  const unsigned voa = (unsigned)(lrow * (int)rs + lkc) * 2u, vona = (unsigned)(lrow * (int)nrs + lkc) * 2u, vob = (unsigned)(lrow * LDW + lkc) * 2u;
  bf16_t* sA = sm; bf16_t* sB = sm + 2 * 128 * 64;
#pragma unroll
  for (int i = 0; i < 4; ++i) *(u32x4*)&sA[(lrow + 32 * i) * 64 + wsw] = ra0[i];
#pragma unroll
  for (int i = 0; i < 4; ++i) *(u32x4*)&sB[(lrow + 32 * i) * 64 + wsw] = rb0[i];
  __syncthreads();
  const int f = (lr >> 1) & 7;
  const int rsw0 = (g ^ f) * 8, rsw1 = ((4 + g) ^ f) * 8;
  const bf16_t* cA0 = sA + (wm * 64 + lr) * 64;
  const bf16_t* cB0 = sB + (wn * 64 + lr) * 64;
  auto compute = [&](int cur) {
    const bf16_t* cA = cA0 + cur * 128 * 64;
    const bf16_t* cB = cB0 + cur * 128 * 64;
#pragma unroll
    for (int ks = 0; ks < 2; ++ks) {
      const int rsw = ks ? rsw1 : rsw0;
      bf16x8 af[4];
#pragma unroll
      for (int t = 0; t < 4; ++t) af[t] = ldfrag(cA + t * 16 * 64 + rsw);
#pragma unroll
      for (int nt = 0; nt < 4; ++nt) {
        const bf16x8 bfr = ldfrag(cB + nt * 16 * 64 + rsw);
#pragma unroll
        for (int mt = 0; mt < 4; ++mt) {
          if (SWAP) acc[mt][nt] = mma(bfr, af[mt], acc[mt][nt]);
          else acc[mt][nt] = mma(af[mt], bfr, acc[mt][nt]);
        }
      }
    }
  };
#pragma unroll 1
  for (int kt = 0; kt < 16; kt += 2) {
    {
      const bool tail = (kt + 2 >= 16);
      const bf16_t* a_ = tail ? nap : ap + (kt + 2) * 64;
      const bf16_t* b_ = tail ? nbp : bp + (kt + 2) * 64;
      const long rs_ = tail ? nrs : rs;
      const unsigned va_ = tail ? vona : voa;
#pragma unroll
      for (int i = 0; i < 4; ++i) ra0[i] = *(const u32x4*)((const char*)(a_ + (long)(32 * i) * rs_) + va_);
#pragma unroll
      for (int i = 0; i < 4; ++i) rb0[i] = *(const u32x4*)((const char*)(b_ + (long)(32 * i) * LDW) + vob);
    }
    compute(0);
    {
      bf16_t* nA = sA + 128 * 64; bf16_t* nB = sB + 128 * 64;
#pragma unroll
      for (int i = 0; i < 4; ++i) *(u32x4*)&nA[(lrow + 32 * i) * 64 + wsw] = ra1[i];
#pragma unroll
      for (int i = 0; i < 4; ++i) *(u32x4*)&nB[(lrow + 32 * i) * 64 + wsw] = rb1[i];
    }
    __syncthreads();
    {
      const bool tail = (kt + 3 >= 16);
      const bf16_t* a_ = tail ? nap + 64 : ap + (kt + 3) * 64;
      const bf16_t* b_ = tail ? nbp + 64 : bp + (kt + 3) * 64;
      const long rs_ = tail ? nrs : rs;
      const unsigned va_ = tail ? vona : voa;
#pragma unroll
      for (int i = 0; i < 4; ++i) ra1[i] = *(const u32x4*)((const char*)(a_ + (long)(32 * i) * rs_) + va_);
#pragma unroll
      for (int i = 0; i < 4; ++i) rb1[i] = *(const u32x4*)((const char*)(b_ + (long)(32 * i) * LDW) + vob);
    }
    compute(1);
    if (kt + 2 < 16) {
#pragma unroll
      for (int i = 0; i < 4; ++i) *(u32x4*)&sA[(lrow + 32 * i) * 64 + wsw] = ra0[i];
#pragma unroll
      for (int i = 0; i < 4; ++i) *(u32x4*)&sB[(lrow + 32 * i) * 64 + wsw] = rb0[i];
    }
    __syncthreads();
  }
}

DEVI void p1_epilogue(const P& p, const P1Tile& d, f32x4 (&acc)[4][4], char* smem) {
  const int tid = TID(), lane = tid & 63, wid = tid >> 6, g = lane >> 4, lr = lane & 15;
  const int wm = wid >> 1, wn = wid & 1;
  const int bl = d.bl, j = d.j, n0 = d.n0, gi = d.gi, dl = d.dl, res = d.res, ib = d.ib;
  const long tokbase = d.tokbase;
  bf16_t* T = (bf16_t*)smem;
  if (d.vt) {
#pragma unroll
    for (int mt = 0; mt < 4; ++mt)
#pragma unroll
      for (int nt = 0; nt < 4; ++nt) {
        const int i0 = wm * 64 + mt * 16 + g * 4;
        const int nl = wn * 64 + nt * 16 + lr;
        u32x2 o; o.x = pk2(acc[mt][nt][0], acc[mt][nt][1]); o.y = pk2(acc[mt][nt][2], acc[mt][nt][3]);
        *(u32x2*)&T[nl * 136 + i0] = o;
      }
    __syncthreads();
#pragma unroll 2
    for (int i = 0; i < 8; ++i) {
      const int c = tid + 256 * i, row = c >> 4, cc = c & 15;
      const u32x4 v = *(const u32x4*)&T[row * 136 + cc * 8];
      const int n = n0 + row;
      bf16_t* dst;
      if (n0 < 1536) { const int cs = n - 1024; dst = p.f_AvT() + ((long)((bl * 4 + (cs >> 7)) * 128 + (cs & 127))) * 2048; }
      else { const int cs = n - 6656 - gi * 512; dst = p.f_DvT() + ((long)(((gi * 8 + bl) * 8 + (cs >> 6)) * 64 + (cs & 63))) * 2048; }
      __builtin_nontemporal_store(v, (u32x4*)(dst + j * 128 + cc * 8));
    }
    __syncthreads();
  } else {
    const bool rope = (n0 < 1024) || (n0 >= 3584 && n0 < 6656);
    const bool sg = (n0 >= YMG);
#pragma unroll
    for (int mt = 0; mt < 4; ++mt) {
      const int i = wm * 64 + mt * 16 + lr;
      const int s = (ib * 128 + i) * dl + res;
#pragma unroll
      for (int nt = 0; nt < 4; ++nt) {
        f32x4 v = acc[mt][nt];
        if (nt == 0 && rope) {
          const float2* tb = p.f_ropeA() + (tokbase + s) * 8 + (g & 1) * 4;
#pragma unroll
          for (int r = 0; r < 4; ++r) {
            const float pv = __shfl_xor(v[r], 32);
            const float2 cs = tb[r];
            v[r] = (g < 2) ? (v[r] * cs.x - pv * cs.y) : (v[r] * cs.x + pv * cs.y);
          }
        }
        if (sg) {
#pragma unroll
          for (int r = 0; r < 4; ++r) v[r] = sigmf(v[r]);
        }
        u32x2 o; o.x = pk2(v[0], v[1]); o.y = pk2(v[2], v[3]);
        *(u32x2*)&T[i * 136 + wn * 64 + nt * 16 + g * 4] = o;
      }
    }
    __syncthreads();
    bf16_t* ybase = p.f_Y() + ((long)(bl * 2048 + j * 128)) * LDY + n0;
#pragma unroll 2
    for (int i = 0; i < 8; ++i) {
      const int c = tid + 256 * i, row = c >> 4, cc = c & 15;
      __builtin_nontemporal_store(*(const u32x4*)&T[row * 136 + cc * 8], (u32x4*)(ybase + (long)row * LDY + cc * 8));
    }
    __syncthreads();
  }
}


template <bool SWAP>
DEVI void gemm_big(const bf16_t* __restrict__ A, long rs, const bf16_t* __restrict__ B, f32x4 (&acc)[4][8], bf16_t* sm) {
  const int tid = TID(), lane = tid & 63, wid = tid >> 6, g = lane >> 4, lr = lane & 15;
  const int wm = wid >> 1, wn = wid & 1;
  const int lrow = tid >> 3, lkc = (tid & 7) * 8;
  const int wsw = ((tid & 7) ^ ((lrow >> 1) & 7)) * 8;
  const unsigned voa = (unsigned)(lrow * (int)rs + lkc) * 2u, vob = (unsigned)(lrow * LDW + lkc) * 2u;
  bf16_t* sA = sm; bf16_t* sB = sm + 128 * 64;
  u32x4 ra[4], rb[8];
#pragma unroll
  for (int i = 0; i < 4; ++i) ra[i] = *(const u32x4*)((const char*)(A + (long)(32 * i) * rs) + voa);
#pragma unroll
  for (int i = 0; i < 8; ++i) rb[i] = *(const u32x4*)((const char*)(B + (long)(32 * i) * LDW) + vob);
  const int f = (lr >> 1) & 7;
  const int rsw0 = (g ^ f) * 8, rsw1 = ((4 + g) ^ f) * 8;
  const bf16_t* cA = sA + (wm * 64 + lr) * 64;
  const bf16_t* cB = sB + (wn * 128 + lr) * 64;
#pragma unroll 1
  for (int kt = 0; kt < 16; ++kt) {
#pragma unroll
    for (int i = 0; i < 4; ++i) *(u32x4*)&sA[(lrow + 32 * i) * 64 + wsw] = ra[i];
#pragma unroll
    for (int i = 0; i < 8; ++i) *(u32x4*)&sB[(lrow + 32 * i) * 64 + wsw] = rb[i];
    __syncthreads();
    {
      const int kn = (kt + 1 < 16 ? kt + 1 : 15) * 64;
#pragma unroll
      for (int i = 0; i < 4; ++i) ra[i] = *(const u32x4*)((const char*)(A + (long)(32 * i) * rs + kn) + voa);
#pragma unroll
      for (int i = 0; i < 8; ++i) rb[i] = *(const u32x4*)((const char*)(B + (long)(32 * i) * LDW + kn) + vob);
    }
#pragma unroll
    for (int ks = 0; ks < 2; ++ks) {
      const int rsw = ks ? rsw1 : rsw0;
      bf16x8 af[4];
#pragma unroll
      for (int t = 0; t < 4; ++t) af[t] = ldfrag(cA + t * 16 * 64 + rsw);
#pragma unroll
      for (int nt = 0; nt < 8; ++nt) {
        const bf16x8 bfr = ldfrag(cB + nt * 16 * 64 + rsw);
#pragma unroll
        for (int mt = 0; mt < 4; ++mt) {
          if (SWAP) acc[mt][nt] = mma(bfr, af[mt], acc[mt][nt]);
          else acc[mt][nt] = mma(af[mt], bfr, acc[mt][nt]);
        }
      }
    }
    __syncthreads();
  }
}

DEVI void p1_desc2(const P& p, int gg, int l, int mtile, int ntile, P1Tile& d) {
  d.bl = mtile >> 4; d.j = mtile & 15; d.n0 = ntile * 256;
  const bool segD = (d.n0 >= 3584 && d.n0 < 8192);
  d.dl = 1; d.gi = 0;
  if (segD) { d.gi = ((d.n0 - 3584) % 1536) / 512; d.dl = d.gi == 0 ? 1 : (d.gi == 1 ? 4 : 16); }
  const int nrb = 16 / d.dl;
  d.res = d.j / nrb; d.ib = d.j % nrb;
  d.tokbase = (long)gg * TG + d.bl * 2048;
  d.A = p.f_h() + (d.tokbase + (long)d.ib * 128 * d.dl + d.res) * LDH;
  d.rs = (long)d.dl * LDH;
  d.B = p.f_wInT() + ((long)l * LDY + d.n0) * LDW;
  d.vt = (d.n0 >= 1024 && d.n0 < 1536) || (d.n0 >= 6656 && d.n0 < 8192);
}

DEVI void p1_tile2(const P& p, const P1Tile& d, char* smem) {
  const int tid = TID(), lane = tid & 63, wid = tid >> 6, g = lane >> 4, lr = lane & 15;
  const int wm = wid >> 1, wn = wid & 1;
  const int bl = d.bl, j = d.j, n0 = d.n0, gi = d.gi, dl = d.dl, res = d.res, ib = d.ib;
  const long tokbase = d.tokbase;
  bf16_t* T = (bf16_t*)smem;
  f32x4 acc[4][8];
#pragma unroll
  for (int a = 0; a < 4; ++a)
#pragma unroll
    for (int b = 0; b < 8; ++b) acc[a][b] = (f32x4){0.f, 0.f, 0.f, 0.f};
  if (d.vt) {
    gemm_big<false>(d.A, d.rs, d.B, acc, (bf16_t*)smem);
#pragma unroll
    for (int mt = 0; mt < 4; ++mt)
#pragma unroll
      for (int nt = 0; nt < 8; ++nt) {
        const int i0 = wm * 64 + mt * 16 + g * 4;
        const int nl = wn * 128 + nt * 16 + lr;
        u32x2 o; o.x = pk2(acc[mt][nt][0], acc[mt][nt][1]); o.y = pk2(acc[mt][nt][2], acc[mt][nt][3]);
        *(u32x2*)&T[nl * 136 + i0] = o;
      }
    __syncthreads();
#pragma unroll 2
    for (int i = 0; i < 16; ++i) {
      const int c = tid + 256 * i, row = c >> 4, cc = c & 15;
      const u32x4 v = *(const u32x4*)&T[row * 136 + cc * 8];
      const int n = n0 + row;
      bf16_t* dst;
      if (n0 < 1536) { const int cs = n - 1024; dst = p.f_AvT() + ((long)((bl * 4 + (cs >> 7)) * 128 + (cs & 127))) * 2048; }
      else { const int cs = n - 6656 - gi * 512; dst = p.f_DvT() + ((long)(((gi * 8 + bl) * 8 + (cs >> 6)) * 64 + (cs & 63))) * 2048; }
      __builtin_nontemporal_store(v, (u32x4*)(dst + j * 128 + cc * 8));
    }
    __syncthreads();
  } else {
    gemm_big<true>(d.A, d.rs, d.B, acc, (bf16_t*)smem);
    const bool rope = (n0 < 1024) || (n0 >= 3584 && n0 < 6656);
    const bool sg = (n0 >= YMG);
#pragma unroll
    for (int mt = 0; mt < 4; ++mt) {
      const int i = wm * 64 + mt * 16 + lr;
      const int s = (ib * 128 + i) * dl + res;
#pragma unroll
      for (int nt = 0; nt < 8; ++nt) {
        f32x4 v = acc[mt][nt];
        if ((nt & 3) == 0 && rope) {
          const float2* tb = p.f_ropeA() + (tokbase + s) * 8 + (g & 1) * 4;
#pragma unroll
          for (int r = 0; r < 4; ++r) {
            const float pv = __shfl_xor(v[r], 32);
            const float2 cs = tb[r];
            v[r] = (g < 2) ? (v[r] * cs.x - pv * cs.y) : (v[r] * cs.x + pv * cs.y);
          }
        }
        if (sg) {
#pragma unroll
          for (int r = 0; r < 4; ++r) v[r] = sigmf(v[r]);
        }
        u32x2 o; o.x = pk2(v[0], v[1]); o.y = pk2(v[2], v[3]);
        *(u32x2*)&T[i * 264 + wn * 128 + nt * 16 + g * 4] = o;
      }
    }
    __syncthreads();
    bf16_t* ybase = p.f_Y() + ((long)(bl * 2048 + j * 128)) * LDY + n0;
#pragma unroll 2
    for (int i = 0; i < 16; ++i) {
      const int c = tid + 256 * i, row = c >> 5, cc = c & 31;
      __builtin_nontemporal_store(*(const u32x4*)&T[row * 264 + cc * 8], (u32x4*)(ybase + (long)row * LDY + cc * 8));
    }
    __syncthreads();
  }
}

DEVI void rowscale_prepass(const bf16_t* __restrict__ A, long rs, int K, float* rsl) {
  const int tid = TID(), row = tid >> 1, half = tid & 1;
  const bf16_t* ap = A + (long)row * rs + half * (K >> 1);
  float ss = 0.f;
  for (int c = 0; c < (K >> 4); ++c) {
    const u32x4 u = *(const u32x4*)(ap + c * 8);
    ss += lo2f(u.x) * lo2f(u.x) + hi2f(u.x) * hi2f(u.x) + lo2f(u.y) * lo2f(u.y) + hi2f(u.y) * hi2f(u.y) +
          lo2f(u.z) * lo2f(u.z) + hi2f(u.z) * hi2f(u.z) + lo2f(u.w) * lo2f(u.w) + hi2f(u.w) * hi2f(u.w);
  }
  ss += __shfl_xor(ss, 1);
  if (half == 0) rsl[row] = rsqrtf(ss / (float)K + EPS);
  __syncthreads();
}

DEVI void p2_qup_tile(const P& p, int gg, int l, int mtile, int ntile, char* smem) {
  const int tid = TID(), lane = tid & 63, wid = tid >> 6, g = lane >> 4, lr = lane & 15;
  const int wm = wid >> 1, wn = wid & 1;
  float* rsl = (float*)(smem + 73728);
  const bf16_t* A = p.f_Y() + (long)(mtile * 128) * LDY + YC;
  rowscale_prepass(A, LDY, 256, rsl);
  f32x4 acc[4][4];
  zero_acc(acc);
  gemm_core<true>(A, LDY, p.f_wUqT() + ((long)l * 768 + ntile * 128) * 256, 256, 256, acc, (bf16_t*)smem);
#pragma unroll
  for (int mt = 0; mt < 4; ++mt) {
    const int i = wm * 64 + mt * 16 + lr;
    const int tokl = mtile * 128 + i;
    const float rsv = rsl[i];
    const float2* tb = p.f_ropeC() + ((long)gg * TG + tokl) * 16 + g * 4;
#pragma unroll
    for (int nt = 0; nt < 4; ++nt) {
      const int colb = ntile * 128 + wn * 64 + nt * 16;
      const int cc = colb % 96;
      f32x4 v = acc[mt][nt] * rsv;
      if (cc == 64) {
        const f32x4 pv = acc[mt][(nt + 1) & 3] * rsv;
#pragma unroll
        for (int r = 0; r < 4; ++r) { const float2 cs = tb[r]; v[r] = v[r] * cs.x - pv[r] * cs.y; }
      } else if (cc == 80) {
        const f32x4 pv = acc[mt][(nt + 3) & 3] * rsv;
#pragma unroll
        for (int r = 0; r < 4; ++r) { const float2 cs = tb[r]; v[r] = v[r] * cs.x + pv[r] * cs.y; }
      }
      u32x2 o; o.x = pk2(v[0], v[1]); o.y = pk2(v[2], v[3]);
      *(u32x2*)(p.f_Qc() + (long)tokl * 768 + colb + g * 4) = o;
    }
  }
  __syncthreads();
}

DEVI void p2_kvup_tile(const P& p, int gg, int l, int mtile, int ntile, char* smem) {
  const int tid = TID(), lane = tid & 63, wid = tid >> 6, g = lane >> 4, lr = lane & 15;
  const int wm = wid >> 1, wn = wid & 1;
  float* rsl = (float*)(smem + 73728);
  const bf16_t* A = p.f_Y() + (long)(mtile * 128) * LDY + YC + 256;
  rowscale_prepass(A, LDY, 128, rsl);
  f32x4 acc[4][4];
  zero_acc(acc);
  const bf16_t* B = p.f_wUkvT() + ((long)l * 1024 + ntile * 128) * 128;
  if (ntile < 4) {
    gemm_core<true>(A, LDY, B, 128, 128, acc, (bf16_t*)smem);
#pragma unroll
    for (int mt = 0; mt < 4; ++mt) {
      const int i = wm * 64 + mt * 16 + lr;
      const int tokl = mtile * 128 + i;
      const float rsv = rsl[i];
#pragma unroll
      for (int nt = 0; nt < 4; ++nt) {
        const int n = ntile * 128 + wn * 64 + nt * 16 + g * 4;
        const f32x4 v = acc[mt][nt] * rsv;
        u32x2 o; o.x = pk2(v[0], v[1]); o.y = pk2(v[2], v[3]);
        *(u32x2*)(p.f_Kc() + (long)tokl * 768 + (n >> 6) * 96 + (n & 63)) = o;
      }
    }
  } else {
    gemm_core<false>(A, LDY, B, 128, 128, acc, (bf16_t*)smem);
    const int bl = mtile >> 4, j = mtile & 15;
#pragma unroll
    for (int mt = 0; mt < 4; ++mt) {
      const int i0 = wm * 64 + mt * 16 + g * 4;
      const float r0 = rsl[i0], r1 = rsl[i0 + 1], r2 = rsl[i0 + 2], r3 = rsl[i0 + 3];
#pragma unroll
      for (int nt = 0; nt < 4; ++nt) {
        const int n = (ntile - 4) * 128 + wn * 64 + nt * 16 + lr;
        u32x2 o; o.x = pk2(acc[mt][nt][0] * r0, acc[mt][nt][1] * r1); o.y = pk2(acc[mt][nt][2] * r2, acc[mt][nt][3] * r3);
        *(u32x2*)(p.f_CvT() + ((long)((bl * 8 + (n >> 6)) * 64 + (n & 63))) * 2048 + j * 128 + i0) = o;
      }
    }
  }
  __syncthreads();
}

DEVI void p2_kpe_item(const P& p, int gg, int item) {
  const int tid = TID();
  const int tokl = item * 128 + (tid >> 1), i0 = (tid & 1) * 8;
  const bf16_t* src = p.f_Y() + (long)tokl * LDY + YKPE;
  const u32x4 a = *(const u32x4*)(src + i0), b = *(const u32x4*)(src + 16 + i0);
  const float2* tb = p.f_ropeC() + ((long)gg * TG + tokl) * 16 + i0;
  float x1[8] = {lo2f(a.x), hi2f(a.x), lo2f(a.y), hi2f(a.y), lo2f(a.z), hi2f(a.z), lo2f(a.w), hi2f(a.w)};
  float x2[8] = {lo2f(b.x), hi2f(b.x), lo2f(b.y), hi2f(b.y), lo2f(b.z), hi2f(b.z), lo2f(b.w), hi2f(b.w)};
  float y1[8], y2[8];
#pragma unroll
  for (int i = 0; i < 8; ++i) { const float2 cs = tb[i]; y1[i] = x1[i] * cs.x - x2[i] * cs.y; y2[i] = x2[i] * cs.x + x1[i] * cs.y; }
  u32x4 o1, o2;
  o1.x = pk2(y1[0], y1[1]); o1.y = pk2(y1[2], y1[3]); o1.z = pk2(y1[4], y1[5]); o1.w = pk2(y1[6], y1[7]);
  o2.x = pk2(y2[0], y2[1]); o2.y = pk2(y2[2], y2[3]); o2.z = pk2(y2[4], y2[5]); o2.w = pk2(y2[6], y2[7]);
#pragma unroll
  for (int hh = 0; hh < 8; ++hh) {
    bf16_t* d = p.f_Kc() + (long)tokl * 768 + hh * 96 + 64 + i0;
    *(u32x4*)d = o1; *(u32x4*)(d + 16) = o2;
  }
}

template <int DQK, int NMAP, int DV, int QT>
DEVI void attn_core(const bf16_t* __restrict__ Q, long ldq, const bf16_t* __restrict__ Kb, long ldk,
                    const bf16_t* __restrict__ VT, long ldv, int kt_lo, int kt_hi, int q0, int win, float scale2,
                    f32x4 (&O)[QT][NMAP][DV / 16], float (&mrun)[QT][NMAP], float (&lrun)[QT][NMAP], bf16_t* sm) {
  constexpr int KC = NMAP * DQK, NKS = DQK / 32, NDT = DV / 16;
  constexpr int KCPR = KC / 8;
  constexpr int KST = (KC > 64) ? 128 : 64;
  constexpr int KXM = (KC > 64) ? 15 : 7;
  constexpr int KCH = 64 * KCPR / 256, VCH = DV * 8 / 256;
  bf16_t* Ks = sm; bf16_t* Vs = sm + 64 * KST;
  const int tid = TID(), lane = tid & 63, wid = tid >> 6, g = lane >> 4, lr = lane & 15;
  bf16x8 qf[QT][NMAP][NKS];
#pragma unroll
  for (int qi = 0; qi < QT; ++qi) {
    const bf16_t* qrow = Q + (long)(qi * 64 + wid * 16 + lr) * ldq;
#pragma unroll
    for (int m = 0; m < NMAP; ++m)
#pragma unroll
      for (int ks = 0; ks < NKS; ++ks) qf[qi][m][ks] = ldfrag(qrow + m * DQK + ks * 32 + g * 8);
  }
#pragma unroll
  for (int qi = 0; qi < QT; ++qi)
#pragma unroll
    for (int m = 0; m < NMAP; ++m) {
      mrun[qi][m] = -1e30f; lrun[qi][m] = 0.f;
#pragma unroll
      for (int dt = 0; dt < NDT; ++dt) O[qi][m][dt] = (f32x4){0.f, 0.f, 0.f, 0.f};
    }
  u32x4 rk[KCH], rv[VCH];
#pragma unroll
  for (int i = 0; i < KCH; ++i) { const int c = tid + 256 * i; rk[i] = *(const u32x4*)(Kb + (long)(kt_lo * 64 + c / KCPR) * ldk + (c % KCPR) * 8); }
#pragma unroll
  for (int i = 0; i < VCH; ++i) { const int c = tid + 256 * i; rv[i] = *(const u32x4*)(VT + (long)(c >> 3) * ldv + kt_lo * 64 + (c & 7) * 8); }
  const int qpos0 = q0 + wid * 16 + lr;
  for (int kt = kt_lo; kt < kt_hi; ++kt) {
    __syncthreads();
#pragma unroll
    for (int i = 0; i < KCH; ++i) {
      const int c = tid + 256 * i, row = c / KCPR, ch = c % KCPR;
      const int fsw = (KC > 64) ? (row & 15) : ((row >> 1) & 7);
      *(u32x4*)&Ks[row * KST + ((ch ^ fsw) & KXM) * 8] = rk[i];
    }
#pragma unroll
    for (int i = 0; i < VCH; ++i) { const int c = tid + 256 * i; *(u32x4*)&Vs[(c >> 3) * 72 + (c & 7) * 8] = rv[i]; }
    __syncthreads();
    if (kt + 1 < kt_hi) {
#pragma unroll
      for (int i = 0; i < KCH; ++i) { const int c = tid + 256 * i; rk[i] = *(const u32x4*)(Kb + (long)((kt + 1) * 64 + c / KCPR) * ldk + (c % KCPR) * 8); }
#pragma unroll
      for (int i = 0; i < VCH; ++i) { const int c = tid + 256 * i; rv[i] = *(const u32x4*)(VT + (long)(c >> 3) * ldv + (kt + 1) * 64 + (c & 7) * 8); }
    }
    const bool need_mask = (kt * 64 + 63 > q0) || (kt * 64 < q0 + (QT * 64 - 1) - win);
    bf16x8 pb[QT][NMAP][2];
#pragma unroll
    for (int m = 0; m < NMAP; ++m) {
      f32x4 s[QT][4];
#pragma unroll
      for (int qi = 0; qi < QT; ++qi)
#pragma unroll
        for (int t4 = 0; t4 < 4; ++t4) s[qi][t4] = (f32x4){0.f, 0.f, 0.f, 0.f};
#pragma unroll
      for (int ks = 0; ks < NKS; ++ks) {
        const int ch = (m * DQK + ks * 32) / 8 + g;
        const int fsw = (KC > 64) ? lr : ((lr >> 1) & 7);
        bf16x8 kf[4];
#pragma unroll
        for (int t4 = 0; t4 < 4; ++t4) kf[t4] = ldfrag(&Ks[(t4 * 16 + lr) * KST + ((ch ^ fsw) & KXM) * 8]);
        __builtin_amdgcn_sched_barrier(0);
#pragma unroll
        for (int qi = 0; qi < QT; ++qi)
#pragma unroll
          for (int t4 = 0; t4 < 4; ++t4) s[qi][t4] = mma(kf[t4], qf[qi][m][ks], s[qi][t4]);
        __builtin_amdgcn_sched_barrier(0);
      }
#pragma unroll
      for (int qi = 0; qi < QT; ++qi) {
        const int qpos = qpos0 + qi * 64;
        float mx = -1e30f;
#pragma unroll
        for (int t4 = 0; t4 < 4; ++t4)
#pragma unroll
          for (int r = 0; r < 4; ++r) {
            float v = s[qi][t4][r];
            if (need_mask) { const int kpos = kt * 64 + t4 * 16 + g * 4 + r; if (kpos > qpos || kpos < qpos - win) v = -1e30f; }
            s[qi][t4][r] = v; mx = fmaxf(mx, v);
          }
        mx = fmaxf(mx, __shfl_xor(mx, 16)); mx = fmaxf(mx, __shfl_xor(mx, 32));
        const float mnew = fmaxf(mrun[qi][m], mx * scale2);
        const float alpha = ex2(mrun[qi][m] - mnew);
        mrun[qi][m] = mnew;
        const float msafe = (mnew < -1e29f) ? 0.f : mnew;
        float ls = 0.f;
#pragma unroll
        for (int t4 = 0; t4 < 4; ++t4)
#pragma unroll
          for (int r = 0; r < 4; ++r) { const float pv = ex2(__builtin_fmaf(s[qi][t4][r], scale2, -msafe)); s[qi][t4][r] = pv; ls += pv; }
        lrun[qi][m] = lrun[qi][m] * alpha + ls;
        if (__builtin_amdgcn_ballot_w64(alpha != 1.f) != 0ull) {
#pragma unroll
          for (int dt = 0; dt < NDT; ++dt) O[qi][m][dt] *= alpha;
        }
#pragma unroll
        for (int kk = 0; kk < 2; ++kk) {
          u32x4 u;
          u.x = pk2(s[qi][2 * kk][0], s[qi][2 * kk][1]); u.y = pk2(s[qi][2 * kk][2], s[qi][2 * kk][3]);
          u.z = pk2(s[qi][2 * kk + 1][0], s[qi][2 * kk + 1][1]); u.w = pk2(s[qi][2 * kk + 1][2], s[qi][2 * kk + 1][3]);
          pb[qi][m][kk] = __builtin_bit_cast(bf16x8, u);
        }
      }
      __builtin_amdgcn_sched_barrier(0);
    }
    {
#pragma unroll
      for (int dg = 0; dg < NDT / 4; ++dg)
#pragma unroll
        for (int kk = 0; kk < 2; ++kk) {
          bf16x8 va[4];
#pragma unroll
          for (int j4 = 0; j4 < 4; ++j4) {
            const int dt = dg * 4 + j4;
            const u32x2 v0 = *(const u32x2*)&Vs[(dt * 16 + lr) * 72 + (2 * kk) * 16 + g * 4];
            const u32x2 v1 = *(const u32x2*)&Vs[(dt * 16 + lr) * 72 + (2 * kk + 1) * 16 + g * 4];
            u32x4 u; u.x = v0.x; u.y = v0.y; u.z = v1.x; u.w = v1.y;
            va[j4] = __builtin_bit_cast(bf16x8, u);
          }
          __builtin_amdgcn_sched_barrier(0);
#pragma unroll
          for (int m = 0; m < NMAP; ++m)
#pragma unroll
            for (int qi = 0; qi < QT; ++qi)
#pragma unroll
              for (int j4 = 0; j4 < 4; ++j4) O[qi][m][dg * 4 + j4] = mma(va[j4], pb[qi][m][kk], O[qi][m][dg * 4 + j4]);
          __builtin_amdgcn_sched_barrier(0);
        }
    }
  }
#pragma unroll
  for (int qi = 0; qi < QT; ++qi)
#pragma unroll
    for (int m = 0; m < NMAP; ++m) { lrun[qi][m] += __shfl_xor(lrun[qi][m], 16); lrun[qi][m] += __shfl_xor(lrun[qi][m], 32); }
  __syncthreads();
}

DEVI void attnA_item(const P& p, int l, int a, char* smem) {
  const int tid = TID(), lane = tid & 63, wid = tid >> 6, g = lane >> 4, lr = lane & 15;
  const int qt = 31 - (a >> 5), bh = a & 31, bl = bh >> 2, hh = bh & 3;
  const bf16_t* Yb = p.f_Y() + (long)(bl * 2048) * LDY;
  f32x4 O1[1][2][8]; float mr1[1][2], ls1[1][2];
  auto& O = O1[0]; auto& mr = mr1[0]; auto& ls = ls1[0];
  attn_core<64, 2, 128, 1>(Yb + (long)(qt * 64) * LDY + YA_Q + hh * 128, LDY, Yb + YA_K + hh * 128, LDY,
                        p.f_AvT() + (long)((bl * 4 + hh) * 128) * 2048, 2048, 0, qt + 1, qt * 64, 1 << 30, 0.125f * LOG2E, O1, mr1, ls1,
                        (bf16_t*)smem);
  (void)mr;
  const float lam = p.f_lam()[l];
  const float lam_init = 0.8f - 0.6f * __expf(-0.3f * (float)l);
  const float i1 = 1.f / ls[0], i2 = lam / ls[1];
  float ss = 0.f;
#pragma unroll
  for (int dt = 0; dt < 8; ++dt)
#pragma unroll
    for (int r = 0; r < 4; ++r) { const float o = O[0][dt][r] * i1 - O[1][dt][r] * i2; O[0][dt][r] = o; ss += o * o; }
  ss += __shfl_xor(ss, 16); ss += __shfl_xor(ss, 32);
  const float rn = rsqrtf(ss * (1.f / 128.f) + EPS) * (1.f - lam_init);
  const int tokl = bl * 2048 + qt * 64 + wid * 16 + lr;
#pragma unroll
  for (int dt = 0; dt < 8; ++dt) {
    const int d = dt * 16 + g * 4;
    const float4 gn = *(const float4*)(p.subln_g + l * 128 + d);
    const u32x2 z = *(const u32x2*)(p.f_Y() + (long)tokl * LDY + YZ + hh * 128 + d);
    u32x2 o;
    o.x = pk2(O[0][dt][0] * rn * gn.x * siluf(lo2f(z.x)), O[0][dt][1] * rn * gn.y * siluf(hi2f(z.x)));
    o.y = pk2(O[0][dt][2] * rn * gn.z * siluf(lo2f(z.y)), O[0][dt][3] * rn * gn.w * siluf(hi2f(z.y)));
    *(u32x2*)(p.f_br() + (long)tokl * 2048 + hh * 128 + d) = o;
  }
}

DEVI void attnC_item(const P& p, int a, char* smem) {
  const int tid = TID(), lane = tid & 63, wid = tid >> 6, g = lane >> 4, lr = lane & 15;
  const int qt = 15 - (a >> 6), bh = a & 63, bl = bh >> 3, hh = bh & 7;
  f32x4 O[2][1][4]; float mr[2][1], ls[2][1];
  attn_core<96, 1, 64, 2>(p.f_Qc() + (long)(bl * 2048 + qt * 128) * 768 + hh * 96, 768, p.f_Kc() + (long)(bl * 2048) * 768 + hh * 96, 768,
                          p.f_CvT() + (long)((bl * 8 + hh) * 64) * 2048, 2048, 0, 2 * qt + 2, qt * 128, 1 << 30, 0.10206207261596575f * LOG2E, O, mr, ls,
                          (bf16_t*)smem);
#pragma unroll
  for (int qi = 0; qi < 2; ++qi) {
    const float il = 1.f / ls[qi][0];
    const int tokl = bl * 2048 + qt * 128 + qi * 64 + wid * 16 + lr;
#pragma unroll
    for (int dt = 0; dt < 4; ++dt) {
      const int d = dt * 16 + g * 4;
      const u32x2 z = *(const u32x2*)(p.f_Y() + (long)tokl * LDY + YZ + 1024 + hh * 64 + d);
      u32x2 o;
      o.x = pk2(O[qi][0][dt][0] * il * siluf(lo2f(z.x)), O[qi][0][dt][1] * il * siluf(hi2f(z.x)));
      o.y = pk2(O[qi][0][dt][2] * il * siluf(lo2f(z.y)), O[qi][0][dt][3] * il * siluf(hi2f(z.y)));
      *(u32x2*)(p.f_br() + (long)tokl * 2048 + 1024 + hh * 64 + d) = o;
    }
  }
}

DEVI void attnD_item(const P& p, int a, char* smem) {
  const int tid = TID(), lane = tid & 63, wid = tid >> 6, g = lane >> 4, lr = lane & 15;
  const int qt = a & 15, rest = a >> 4, hh = rest & 7, bl = (rest >> 3) & 7, gi = rest >> 6;
  const int dl = gi == 0 ? 1 : (gi == 1 ? 4 : 16), L = 2048 / dl;
  const int q0 = qt * 128, ss = (q0 / L) * L;
  const int lo = (q0 - 128 > ss) ? (q0 - 128) : ss;
  const bf16_t* Yb = p.f_Y() + (long)(bl * 2048) * LDY;
  f32x4 O[2][1][4]; float mr[2][1], ls[2][1];
  attn_core<64, 1, 64, 2>(Yb + (long)q0 * LDY + YD_Q + gi * 512 + hh * 64, LDY, Yb + YD_K + gi * 512 + hh * 64, LDY,
                          p.f_DvT() + (long)(((gi * 8 + bl) * 8 + hh) * 64) * 2048, 2048, lo >> 6, 2 * qt + 2, q0, 128, 0.125f * LOG2E, O, mr, ls,
                          (bf16_t*)smem);
#pragma unroll
  for (int qi = 0; qi < 2; ++qi) {
    const float il = 1.f / ls[qi][0];
    const int ppos = q0 + qi * 64 + wid * 16 + lr;
    const int s = (ppos % L) * dl + ppos / L;
    const long tokl = (long)gi * TG + bl * 2048 + s;
#pragma unroll
    for (int dt = 0; dt < 4; ++dt) {
      const int d = dt * 16 + g * 4;
      u32x2 o; o.x = pk2(O[qi][0][dt][0] * il, O[qi][0][dt][1] * il); o.y = pk2(O[qi][0][dt][2] * il, O[qi][0][dt][3] * il);
      *(u32x2*)(p.f_Do() + tokl * 512 + hh * 64 + d) = o;
    }
    if (g == 0) p.f_Dlse()[tokl * 8 + hh] = (mr[qi][0] + __log2f(ls[qi][0])) * LN2;
  }
}

DEVI void dcomb_item(const P& p, int item) {
  const int tid = TID();
  const int tokl = item * 128 + (tid >> 1), h0 = (tid & 1) * 4;
  for (int hq = 0; hq < 4; ++hq) {
    const int hh = h0 + hq;
    const float l0 = p.f_Dlse()[((long)0 * TG + tokl) * 8 + hh], l1 = p.f_Dlse()[((long)1 * TG + tokl) * 8 + hh], l2 = p.f_Dlse()[((long)2 * TG + tokl) * 8 + hh];
    const float mx = fmaxf(l0, fmaxf(l1, l2));
    float w0 = __expf(l0 - mx), w1 = __expf(l1 - mx), w2 = __expf(l2 - mx);
    const float inv = 1.f / (w0 + w1 + w2);
    w0 *= inv; w1 *= inv; w2 *= inv;
#pragma unroll
    for (int c = 0; c < 8; ++c) {
      const int col = hh * 64 + c * 8;
      const u32x4 a = *(const u32x4*)(p.f_Do() + ((long)0 * TG + tokl) * 512 + col);
      const u32x4 b = *(const u32x4*)(p.f_Do() + ((long)1 * TG + tokl) * 512 + col);
      const u32x4 cc = *(const u32x4*)(p.f_Do() + ((long)2 * TG + tokl) * 512 + col);
      const u32x4 z = *(const u32x4*)(p.f_Y() + (long)tokl * LDY + YZ + 1536 + col);
      u32x4 o;
      o.x = pk2((w0 * lo2f(a.x) + w1 * lo2f(b.x) + w2 * lo2f(cc.x)) * siluf(lo2f(z.x)), (w0 * hi2f(a.x) + w1 * hi2f(b.x) + w2 * hi2f(cc.x)) * siluf(hi2f(z.x)));
      o.y = pk2((w0 * lo2f(a.y) + w1 * lo2f(b.y) + w2 * lo2f(cc.y)) * siluf(lo2f(z.y)), (w0 * hi2f(a.y) + w1 * hi2f(b.y) + w2 * hi2f(cc.y)) * siluf(hi2f(z.y)));
      o.z = pk2((w0 * lo2f(a.z) + w1 * lo2f(b.z) + w2 * lo2f(cc.z)) * siluf(lo2f(z.z)), (w0 * hi2f(a.z) + w1 * hi2f(b.z) + w2 * hi2f(cc.z)) * siluf(hi2f(z.z)));
      o.w = pk2((w0 * lo2f(a.w) + w1 * lo2f(b.w) + w2 * lo2f(cc.w)) * siluf(lo2f(z.w)), (w0 * hi2f(a.w) + w1 * hi2f(b.w) + w2 * hi2f(cc.w)) * siluf(hi2f(z.w)));
      *(u32x4*)(p.f_br() + (long)tokl * 2048 + 1536 + col) = o;
    }
  }
}

DEVI void b1_item(const P& p, int l, int item, char* smem) {
  const int tid = TID(), lane = tid & 63, wid = tid >> 6, g = lane >> 4, lr = lane & 15;
  const int n = item & 31, hh = (item >> 5) & 3, bl = item >> 7;
  const int tok0 = bl * 2048 + n * 64;
  bf16_t* qs = (bf16_t*)smem;
  bf16_t* ks = qs + 64 * 136;
  bf16_t* vs = ks + 64 * 136;
  float* Lm = (float*)(smem + 52224);
  float* gcs = (float*)(smem + 52224 + 17408);
  float* betas = gcs + 64;
#pragma unroll 1
  for (int it = 0; it < 12; ++it) {
    const int part = it >> 2;
    const int wi = (it & 3) * 256 + tid;
    const int t = wi >> 4, c0 = (wi & 15) * 8;
    const int ccol = part * 512 + hh * 128 + c0;
    float acc[8];
#pragma unroll
    for (int e = 0; e < 8; ++e) acc[e] = 0.f;
#pragma unroll
    for (int jj = 0; jj < 4; ++jj) {
      const int sidx = n * 64 + t - 3 + jj;
      if (sidx >= 0) {
        const u32x4 xv = *(const u32x4*)(p.f_Y() + (long)(bl * 2048 + sidx) * LDY + YB_Q + ccol);
        const float4 wa = *(const float4*)(p.conv_b + ((long)l * 4 + jj) * 1536 + ccol);
        const float4 wb = *(const float4*)(p.conv_b + ((long)l * 4 + jj) * 1536 + ccol + 4);
        acc[0] += lo2f(xv.x) * wa.x; acc[1] += hi2f(xv.x) * wa.y; acc[2] += lo2f(xv.y) * wa.z; acc[3] += hi2f(xv.y) * wa.w;
        acc[4] += lo2f(xv.z) * wb.x; acc[5] += hi2f(xv.z) * wb.y; acc[6] += lo2f(xv.w) * wb.z; acc[7] += hi2f(xv.w) * wb.w;
      }
    }
    float ssq = 0.f;
#pragma unroll
    for (int e = 0; e < 8; ++e) { acc[e] = siluf(acc[e]); ssq += acc[e] * acc[e]; }
    float sc = 1.f;
    if (part < 2) {
      ssq += __shfl_xor(ssq, 1); ssq += __shfl_xor(ssq, 2); ssq += __shfl_xor(ssq, 4); ssq += __shfl_xor(ssq, 8);
      sc = rsqrtf(ssq + EPS);
      if (part == 0) sc *= 0.08838834764831845f;
    }
    u32x4 o;
    o.x = pk2(acc[0] * sc, acc[1] * sc); o.y = pk2(acc[2] * sc, acc[3] * sc); o.z = pk2(acc[4] * sc, acc[5] * sc); o.w = pk2(acc[6] * sc, acc[7] * sc);
    bf16_t* dst = (part == 0 ? qs : (part == 1 ? ks : vs)) + t * 136 + c0;
    *(u32x4*)dst = o;
  }
  if (wid == 0) {
    const bf16_t* yr = p.f_Y() + (long)(tok0 + lane) * LDY;
    const float bv = sigmf(bf2f(yr[YBETA + hh]));
    const float xd = bf2f(yr[YDECAY + hh]) + p.dt_bias[l * 4 + hh];
    const float sp = (xd > 20.f) ? xd : log1pf(__expf(xd));
    float gc = -__expf(p.a_log[l * 4 + hh]) * sp;
#pragma unroll
    for (int o = 1; o < 64; o <<= 1) { const float v = __shfl_up(gc, o); if (lane >= o) gc += v; }
    gcs[lane] = gc; betas[lane] = bv;
  }
  __syncthreads();
  {
    bf16_t* qkdst = p.f_QKm() + (long)item * 4096;
#pragma unroll
    for (int nt = 0; nt < 4; ++nt) {
      f32x4 akk = (f32x4){0.f, 0.f, 0.f, 0.f}, aqk = (f32x4){0.f, 0.f, 0.f, 0.f};
#pragma unroll
      for (int k4 = 0; k4 < 4; ++k4) {
        const bf16x8 bfr = ldfrag(&ks[(nt * 16 + lr) * 136 + k4 * 32 + g * 8]);
        akk = mma(ldfrag(&ks[(wid * 16 + lr) * 136 + k4 * 32 + g * 8]), bfr, akk);
        aqk = mma(ldfrag(&qs[(wid * 16 + lr) * 136 + k4 * 32 + g * 8]), bfr, aqk);
      }
      const int jc = nt * 16 + lr;
      const float gj = gcs[jc];
      float lt4[4];
#pragma unroll
      for (int r = 0; r < 4; ++r) {
        const int i = wid * 16 + g * 4 + r;
        const float dec = (i >= jc) ? __expf(gcs[i] - gj) : 0.f;
        lt4[r] = (i > jc) ? betas[i] * akk[r] * dec : 0.f;
        qkdst[i * 64 + jc] = f2bf(aqk[r] * dec);
      }
      *(float4*)&Lm[jc * 68 + wid * 16 + g * 4] = make_float4(lt4[0], lt4[1], lt4[2], lt4[3]);
    }
  }
  {
    const float glast = gcs[63];
#pragma unroll
    for (int it = 0; it < 4; ++it) {
      const int idx = tid + 256 * it;
      const int i = idx >> 4, c0 = (idx & 15) * 8;
      const float e = __expf(gcs[i]);
      const u32x4 u = *(const u32x4*)&qs[i * 136 + c0];
      u32x4 o;
      o.x = pk2(lo2f(u.x) * e, hi2f(u.x) * e); o.y = pk2(lo2f(u.y) * e, hi2f(u.y) * e); o.z = pk2(lo2f(u.z) * e, hi2f(u.z) * e); o.w = pk2(lo2f(u.w) * e, hi2f(u.w) * e);
      *(u32x4*)(p.f_QG() + (long)item * 8192 + i * 128 + c0) = o;
    }
    const int dk = tid >> 1, ih = (tid & 1) * 32;
    bf16_t* d = p.f_KGT() + (long)item * 8192 + dk * 64 + ih;
#pragma unroll
    for (int q = 0; q < 4; ++q) {
      float v[8];
#pragma unroll
      for (int e = 0; e < 8; ++e) { const int i = ih + q * 8 + e; v[e] = bf2f(ks[i * 136 + dk]) * __expf(glast - gcs[i]); }
      u32x4 o; o.x = pk2(v[0], v[1]); o.y = pk2(v[2], v[3]); o.z = pk2(v[4], v[5]); o.w = pk2(v[6], v[7]);
      *(u32x4*)(d + q * 8) = o;
    }
    if (tid == 0) p.f_dlast()[item] = __expf(glast);
  }
  __syncthreads();
  {
    const int which = wid >> 1, c = (wid & 1) * 64 + lane;
    const bf16_t* rsrc = which == 0 ? vs : ks;
    bf16_t* xdst = which == 0 ? vs : qs;
#pragma unroll 1
    for (int ib = 0; ib < 4; ++ib) {
      float a[16];
#pragma unroll
      for (int r = 0; r < 16; ++r) {
        const int i = ib * 16 + r;
        float rhs = bf2f(rsrc[i * 136 + c]) * betas[i];
        if (which) rhs *= __expf(gcs[i]);
        a[r] = rhs;
      }
#pragma unroll 1
      for (int j = 0; j < ib * 16; ++j) {
        const float xj = bf2f(xdst[j * 136 + c]);
        const float4 l0 = *(const float4*)&Lm[j * 68 + ib * 16 + 0], l1 = *(const float4*)&Lm[j * 68 + ib * 16 + 4];
        const float4 l2 = *(const float4*)&Lm[j * 68 + ib * 16 + 8], l3 = *(const float4*)&Lm[j * 68 + ib * 16 + 12];
        a[0] -= l0.x * xj; a[1] -= l0.y * xj; a[2] -= l0.z * xj; a[3] -= l0.w * xj;
        a[4] -= l1.x * xj; a[5] -= l1.y * xj; a[6] -= l1.z * xj; a[7] -= l1.w * xj;
        a[8] -= l2.x * xj; a[9] -= l2.y * xj; a[10] -= l2.z * xj; a[11] -= l2.w * xj;
        a[12] -= l3.x * xj; a[13] -= l3.y * xj; a[14] -= l3.z * xj; a[15] -= l3.w * xj;
      }
#pragma unroll
      for (int jj = 0; jj < 15; ++jj) {
        const float xj = a[jj];
        const float* lrow = &Lm[(ib * 16 + jj) * 68 + ib * 16];
#pragma unroll
        for (int r4 = 0; r4 < 4; ++r4) {
          if (r4 * 4 + 3 > jj) {
            const float4 lv = *(const float4*)(lrow + r4 * 4);
            if (r4 * 4 + 0 > jj) a[r4 * 4 + 0] -= lv.x * xj;
            if (r4 * 4 + 1 > jj) a[r4 * 4 + 1] -= lv.y * xj;
            if (r4 * 4 + 2 > jj) a[r4 * 4 + 2] -= lv.z * xj;
            if (r4 * 4 + 3 > jj) a[r4 * 4 + 3] -= lv.w * xj;
          }
        }
      }
#pragma unroll
      for (int r = 0; r < 16; ++r) xdst[(ib * 16 + r) * 136 + c] = f2bf(a[r]);
      if (which == 0) {
        bf16_t* d = p.f_UT() + (long)item * 8192 + c * 64 + ib * 16;
        u32x4 o0, o1;
        o0.x = pk2(a[0], a[1]); o0.y = pk2(a[2], a[3]); o0.z = pk2(a[4], a[5]); o0.w = pk2(a[6], a[7]);
        o1.x = pk2(a[8], a[9]); o1.y = pk2(a[10], a[11]); o1.z = pk2(a[12], a[13]); o1.w = pk2(a[14], a[15]);
        *(u32x4*)d = o0; *(u32x4*)(d + 8) = o1;
      } else {
        bf16_t* d = p.f_Wm() + (long)item * 8192 + (ib * 16) * 128 + c;
#pragma unroll
        for (int r = 0; r < 16; ++r) d[r * 128] = f2bf(a[r]);
      }
    }
  }
  __syncthreads();
}

DEVI void b2_item(const P& p, int l, int item, char* smem) {
  const int tid = TID(), lane = tid & 63, wid = tid >> 6, g = lane >> 4, lr = lane & 15;
  const int bl = item >> 2, hh = item & 3;
  bf16_t* ST = (bf16_t*)smem;
  bf16_t* VNT = ST + 128 * 144;
  for (int i = tid; i < 128 * 144 / 2; i += 256) ((unsigned*)ST)[i] = 0u;
  f32x4 Sacc[2][8];
#pragma unroll
  for (int a = 0; a < 2; ++a)
#pragma unroll
    for (int b = 0; b < 8; ++b) Sacc[a][b] = (f32x4){0.f, 0.f, 0.f, 0.f};
  bf16x8 fw[4], fq[4], fqk[2], fk[2][2];
  u32x2 fu[8], fz[8];
  float dlv;
  const long it0 = (long)item * 32;
  const long tok0 = (long)bl * 2048 + wid * 16 + lr;
  const bf16_t* zbase = p.f_Y() + YZ + 512 + hh * 128 + (long)bl * 2048 * LDY;
  const unsigned vW = (unsigned)((wid * 16 + lr) * 128 + g * 8) * 2u;
  const unsigned vU = (unsigned)(lr * 64 + wid * 16 + g * 4) * 2u;
  const unsigned vQ = (unsigned)((wid * 16 + lr) * 64 + g * 8) * 2u;
  const unsigned vK = (unsigned)((2 * wid * 16 + lr) * 64 + g * 8) * 2u;
  const unsigned vZ = (unsigned)((wid * 16 + lr) * LDY + g * 4) * 2u;
#define LDF(base, voff) (*(const bf16x8*)((const char*)(base) + (voff)))
#define LD2(base, voff) (*(const u32x2*)((const char*)(base) + (voff)))
  {
    const bf16_t* Wp = p.f_Wm() + it0 * 8192; const bf16_t* UTp = p.f_UT() + it0 * 8192; const bf16_t* QGp0 = p.f_QG() + it0 * 8192;
#pragma unroll
    for (int k4 = 0; k4 < 4; ++k4) { fw[k4] = LDF(Wp + k4 * 32, vW); fq[k4] = LDF(QGp0 + k4 * 32, vW); }
    {
      const bf16_t* QKp = p.f_QKm() + it0 * 4096; const bf16_t* KGp = p.f_KGT() + it0 * 8192;
#pragma unroll
      for (int k2 = 0; k2 < 2; ++k2) { fqk[k2] = LDF(QKp + k2 * 32, vQ); fk[0][k2] = LDF(KGp + k2 * 32, vK); fk[1][k2] = LDF(KGp + 16 * 64 + k2 * 32, vK); }
#pragma unroll
      for (int nt = 0; nt < 8; ++nt) fz[nt] = LD2(zbase + nt * 16, vZ);
      dlv = p.f_dlast()[it0];
    }
#pragma unroll
    for (int nt = 0; nt < 8; ++nt) fu[nt] = LD2(UTp + nt * 16 * 64, vU);
  }
#pragma unroll 1
  for (int n = 0; n < 32; ++n) {
    const int nn = (n + 1 < 32) ? n + 1 : 31;
    const long itn = it0 + nn;
    const long tokl = tok0 + n * 64;
    {
      const long it = it0 + n;
    }
    __syncthreads();
    f32x4 ao[8];
#pragma unroll
    for (int hf = 0; hf < 2; ++hf) {
      f32x4 av[4];
#pragma unroll
      for (int q4 = 0; q4 < 4; ++q4) av[q4] = (f32x4){0.f, 0.f, 0.f, 0.f};
#pragma unroll
      for (int k4 = 0; k4 < 4; ++k4) {
        bf16x8 fa[4];
#pragma unroll
        for (int q4 = 0; q4 < 4; ++q4) fa[q4] = ldfrag(&ST[((hf * 4 + q4) * 16 + lr) * 144 + k4 * 32 + g * 8]);
        __builtin_amdgcn_sched_barrier(0);
#pragma unroll
        for (int q4 = 0; q4 < 4; ++q4) av[q4] = mma(fw[k4], fa[q4], av[q4]);
        __builtin_amdgcn_sched_barrier(0);
      }
#pragma unroll
      for (int q4 = 0; q4 < 4; ++q4) {
        const int nt = hf * 4 + q4;
        u32x2 o; o.x = pk2(lo2f(fu[nt].x) - av[q4][0], hi2f(fu[nt].x) - av[q4][1]); o.y = pk2(lo2f(fu[nt].y) - av[q4][2], hi2f(fu[nt].y) - av[q4][3]);
        *(u32x2*)&VNT[(nt * 16 + lr) * 80 + wid * 16 + g * 4] = o;
      }
      __builtin_amdgcn_sched_barrier(0);
    }
    {
      const bf16_t* Wp = p.f_Wm() + itn * 8192; const bf16_t* UTp = p.f_UT() + itn * 8192;
#pragma unroll
      for (int k4 = 0; k4 < 4; ++k4) fw[k4] = LDF(Wp + k4 * 32, vW);
#pragma unroll
      for (int nt = 0; nt < 8; ++nt) fu[nt] = LD2(UTp + nt * 16 * 64, vU);
    }
#pragma unroll
    for (int nt = 0; nt < 8; ++nt) ao[nt] = (f32x4){0.f, 0.f, 0.f, 0.f};
#pragma unroll
    for (int gi = 0; gi < 8; ++gi) {
      bf16x8 fa[4];
#pragma unroll
      for (int q4 = 0; q4 < 4; ++q4) fa[q4] = ldfrag(&ST[(((gi & 1) * 4 + q4) * 16 + lr) * 144 + (gi >> 1) * 32 + g * 8]);
      __builtin_amdgcn_sched_barrier(0);
#pragma unroll
      for (int q4 = 0; q4 < 4; ++q4) ao[(gi & 1) * 4 + q4] = mma(fa[q4], fq[gi >> 1], ao[(gi & 1) * 4 + q4]);
      __builtin_amdgcn_sched_barrier(0);
    }
    __builtin_amdgcn_sched_barrier(0);
    {
      const bf16_t* QGp = p.f_QG() + itn * 8192;
#pragma unroll
      for (int k4 = 0; k4 < 4; ++k4) fq[k4] = LDF(QGp + k4 * 32, vW);
    }
    __syncthreads();
#pragma unroll
    for (int gi = 0; gi < 4; ++gi) {
      bf16x8 fa[4];
#pragma unroll
      for (int q4 = 0; q4 < 4; ++q4) fa[q4] = ldfrag(&VNT[(((gi & 1) * 4 + q4) * 16 + lr) * 80 + (gi >> 1) * 32 + g * 8]);
      __builtin_amdgcn_sched_barrier(0);
#pragma unroll
      for (int q4 = 0; q4 < 4; ++q4) ao[(gi & 1) * 4 + q4] = mma(fa[q4], fqk[gi >> 1], ao[(gi & 1) * 4 + q4]);
      __builtin_amdgcn_sched_barrier(0);
    }
    __builtin_amdgcn_sched_barrier(0);
    {
      const bf16_t* QKp = p.f_QKm() + itn * 4096;
#pragma unroll
      for (int k2 = 0; k2 < 2; ++k2) fqk[k2] = LDF(QKp + k2 * 32, vQ);
    }
    {
      float ss = 0.f;
#pragma unroll
      for (int nt = 0; nt < 8; ++nt)
#pragma unroll
        for (int r = 0; r < 4; ++r) ss += ao[nt][r] * ao[nt][r];
      ss += __shfl_xor(ss, 16); ss += __shfl_xor(ss, 32);
      const float rn = rsqrtf(ss * (1.f / 128.f) + EPS);
#pragma unroll
      for (int nt = 0; nt < 8; ++nt) {
        const int dv = nt * 16 + g * 4;
        const float4 gn = *(const float4*)(p.out_norm_b + l * 128 + dv);
        u32x2 o;
        o.x = pk2(ao[nt][0] * rn * gn.x * siluf(lo2f(fz[nt].x)), ao[nt][1] * rn * gn.y * siluf(hi2f(fz[nt].x)));
        o.y = pk2(ao[nt][2] * rn * gn.z * siluf(lo2f(fz[nt].y)), ao[nt][3] * rn * gn.w * siluf(hi2f(fz[nt].y)));
        *(u32x2*)(p.f_br() + tokl * 2048 + 512 + hh * 128 + dv) = o;
      }
    }
    __builtin_amdgcn_sched_barrier(0);
    {
#pragma unroll
      for (int nt = 0; nt < 8; ++nt) fz[nt] = LD2(zbase + (long)(nn * 64) * LDY + nt * 16, vZ);
    }
#pragma unroll
    for (int a = 0; a < 2; ++a)
#pragma unroll
      for (int nt = 0; nt < 8; ++nt) Sacc[a][nt] *= dlv;
#pragma unroll
    for (int gi = 0; gi < 4; ++gi) {
      bf16x8 fa[4];
#pragma unroll
      for (int q4 = 0; q4 < 4; ++q4) fa[q4] = ldfrag(&VNT[(((gi & 1) * 4 + q4) * 16 + lr) * 80 + (gi >> 1) * 32 + g * 8]);
      __builtin_amdgcn_sched_barrier(0);
#pragma unroll
      for (int q4 = 0; q4 < 4; ++q4) {
        const int nt = (gi & 1) * 4 + q4;
        Sacc[0][nt] = mma(fk[0][gi >> 1], fa[q4], Sacc[0][nt]); Sacc[1][nt] = mma(fk[1][gi >> 1], fa[q4], Sacc[1][nt]);
      }
      __builtin_amdgcn_sched_barrier(0);
    }
    __builtin_amdgcn_sched_barrier(0);
    {
      const bf16_t* KGp = p.f_KGT() + itn * 8192;
#pragma unroll
      for (int k2 = 0; k2 < 2; ++k2) { fk[0][k2] = LDF(KGp + k2 * 32, vK); fk[1][k2] = LDF(KGp + 16 * 64 + k2 * 32, vK); }
      dlv = p.f_dlast()[itn];
    }
#pragma unroll
    for (int a = 0; a < 2; ++a)
#pragma unroll
      for (int nt = 0; nt < 8; ++nt) {
        u32x2 o; o.x = pk2(Sacc[a][nt][0], Sacc[a][nt][1]); o.y = pk2(Sacc[a][nt][2], Sacc[a][nt][3]);
        *(u32x2*)&ST[(nt * 16 + lr) * 144 + (2 * wid + a) * 16 + g * 4] = o;
      }
  }
  __syncthreads();
}

DEVI void p4a_tile(const P& p, int l, int mtile, int ntile, char* smem) {
  const int tid = TID(), lane = tid & 63, wid = tid >> 6, g = lane >> 4, lr = lane & 15;
  const int wm = wid >> 1, wn = wid & 1;
  f32x4 tot[4][4];
  zero_acc(tot);
#pragma unroll 1
  for (int nb = 0; nb < 4; ++nb) {
    f32x4 acc[4][4];
    zero_acc(acc);
    gemm_core<true, 4>(p.f_br() + (long)(mtile * 128) * 2048 + nb * 512, 2048, p.f_wBrT() + ((long)((l * 4 + nb) * 1024) + ntile * 128) * 512, 512, 512, acc,
                       (bf16_t*)smem);
#pragma unroll
    for (int mt = 0; mt < 4; ++mt) {
      const long tokl = mtile * 128 + wm * 64 + mt * 16 + lr;
#pragma unroll
      for (int nt = 0; nt < 4; ++nt) {
        const int col = ntile * 128 + wn * 64 + nt * 16 + g * 4;
        const u32x2 gt = *(const u32x2*)(p.f_Y() + tokl * LDY + YMG + nb * 1024 + col);
        tot[mt][nt][0] += acc[mt][nt][0] * lo2f(gt.x); tot[mt][nt][1] += acc[mt][nt][1] * hi2f(gt.x);
        tot[mt][nt][2] += acc[mt][nt][2] * lo2f(gt.y); tot[mt][nt][3] += acc[mt][nt][3] * hi2f(gt.y);
      }
    }
  }
#pragma unroll
  for (int mt = 0; mt < 4; ++mt) {
    const long tokl = mtile * 128 + wm * 64 + mt * 16 + lr;
#pragma unroll
    for (int nt = 0; nt < 4; ++nt) {
      const int col = ntile * 128 + wn * 64 + nt * 16 + g * 4;
      u32x2 o; o.x = pk2(tot[mt][nt][0], tot[mt][nt][1]); o.y = pk2(tot[mt][nt][2], tot[mt][nt][3]);
      *(u32x2*)(p.f_merged() + tokl * 1024 + col) = o;
    }
  }
}

DEVI void p4b_tile(const P& p, int gg, int l, int mtile, int ntile, char* smem) {
  const int tid = TID(), lane = tid & 63, wid = tid >> 6, g = lane >> 4, lr = lane & 15;
  const int wm = wid >> 1, wn = wid & 1;
  f32x4 acc[4][4];
  zero_acc(acc);
  gemm_core<true>(p.f_merged() + (long)(mtile * 128) * 1024, 1024, p.f_wOutT() + ((long)l * 1024 + ntile * 128) * 1024, 1024, 1024, acc, (bf16_t*)smem);
  const float* xin = (l == 0) ? p.x : p.out;
  const int bglob = gg * NB + (mtile >> 4);
  const float* gate = p.f_mod() + (long)(l * 32 + bglob) * 3072 + 2048;
  const float alpha = 1.4142135623730951f;
#pragma unroll
  for (int mt = 0; mt < 4; ++mt) {
    const long tok = (long)gg * TG + mtile * 128 + wm * 64 + mt * 16 + lr;
#pragma unroll
    for (int nt = 0; nt < 4; ++nt) {
      const int col = ntile * 128 + wn * 64 + nt * 16 + g * 4;
      const float4 xv = *(const float4*)(xin + tok * 1024 + col);
      const float4 gv = *(const float4*)(gate + col);
      float4 o;
      o.x = alpha * xv.x + gv.x * acc[mt][nt][0]; o.y = alpha * xv.y + gv.y * acc[mt][nt][1];
      o.z = alpha * xv.z + gv.z * acc[mt][nt][2]; o.w = alpha * xv.w + gv.w * acc[mt][nt][3];
      *(float4*)(p.out + tok * 1024 + col) = o;
    }
  }
}

DEVI void p4c_row(const P& p, int gg, int l, long tok, int lane) {
  float* r = p.out + tok * 1024;
  float4 v[4];
#pragma unroll
  for (int i = 0; i < 4; ++i) v[i] = *(const float4*)(r + i * 256 + lane * 4);
  float mu, rstd;
  ln_stats(v, mu, rstd);
#pragma unroll
  for (int i = 0; i < 4; ++i) {
    const int col = i * 256 + lane * 4;
    const float4 gn = *(const float4*)(p.ln_g + l * 1024 + col), bb = *(const float4*)(p.ln_b + l * 1024 + col);
    v[i].x = (v[i].x - mu) * rstd * gn.x + bb.x; v[i].y = (v[i].y - mu) * rstd * gn.y + bb.y;
    v[i].z = (v[i].z - mu) * rstd * gn.z + bb.z; v[i].w = (v[i].w - mu) * rstd * gn.w + bb.w;
    *(float4*)(r + col) = v[i];
  }
  if (l == 0) {
    ln_stats(v, mu, rstd);
    const int b = (int)(tok >> 11);
    store_h(v, mu, rstd, p.f_mod() + (long)(1 * 32 + b) * 3072, p.f_h() + tok * LDH, lane);
  }
}


#define XB_TMO      128
#define XB_XCNT(j)  (256  + 64 * (j))
#define XB_XSUB(j)  (1280 + 64 * (j))
#define XB_XGEN(j)  (2304 + 64 * (j))
#define XB_TOP      3328
#define XB_TOPGEN   3392
#define XCD_BAR_WORDS 3456
#define XB_SPIN_CAP (1u << 22)
#define LAS __attribute__((address_space(3)))
DEVI unsigned xb_ld(unsigned* p) { return __hip_atomic_load(p, __ATOMIC_RELAXED, __HIP_MEMORY_SCOPE_AGENT); }
DEVI unsigned xb_add(unsigned* p, unsigned v) { return __hip_atomic_fetch_add(p, v, __ATOMIC_RELAXED, __HIP_MEMORY_SCOPE_AGENT); }
DEVI unsigned xb_xcc_id() { return (unsigned)__builtin_amdgcn_s_getreg((3 << 11) | 20) & 0xFu; }
#define XB_SPIN(cond, bar) do { unsigned _sp = 0; while (cond) { __builtin_amdgcn_s_sleep(1); \
    if ((++_sp & 255u) == 0u) { if (xb_ld(&(bar)[XB_TMO])) break; if (_sp > XB_SPIN_CAP) { atomicAdd(&(bar)[XB_TMO], 1u); break; } } } } while (0)
struct XcdBarrier { unsigned* bar; unsigned x; volatile LAS unsigned* st; };
DEVI XcdBarrier xcd_barrier_post(unsigned* bar, volatile LAS unsigned* st) {
  XcdBarrier b; b.bar = bar; b.x = xb_xcc_id(); b.st = st;
  if (threadIdx.x == 0) (void)xb_add(&bar[XB_XCNT(b.x)], 1u);
  return b;
}
DEVI void xcd_barrier_complete(unsigned* bar, unsigned x, unsigned& nloc, unsigned& nx) {
  const unsigned G = gridDim.x * gridDim.y * gridDim.z;
  unsigned sum, cnt, mine, sp = 0u;
  for (;;) {
    sum = 0u; cnt = 0u; mine = 0u;
#pragma unroll
    for (unsigned j = 0; j < 16; ++j) { const unsigned c = xb_ld(&bar[XB_XCNT(j)]); sum += c; cnt += (c > 0u) ? 1u : 0u; mine = (j == x) ? c : mine; }
    if (sum == G) break;
    __builtin_amdgcn_s_sleep(1);
    if ((++sp & 255u) == 0u) { if (xb_ld(&bar[XB_TMO])) break; if (sp > XB_SPIN_CAP) { atomicAdd(&bar[XB_TMO], 1u); break; } }
  }
  nloc = mine > 0u ? mine : 1u; nx = cnt > 0u ? cnt : 1u;
}
DEVI void xcd_barrier(const XcdBarrier& b) {
  asm volatile("s_waitcnt vmcnt(0)" ::: "memory");
  __syncthreads();
  if (threadIdx.x == 0) {
    unsigned* bar = b.bar;
    __builtin_amdgcn_s_waitcnt(0);
    unsigned nloc = b.st[0], nx = b.st[1];
    if (nloc == 0u) { xcd_barrier_complete(bar, b.x, nloc, nx); b.st[0] = nloc; b.st[1] = nx; }
    const unsigned old = xb_add(&bar[XB_XSUB(b.x)], 1u);
    const unsigned gen = old / nloc;
    if (old + 1u == (gen + 1u) * nloc) {
      __builtin_amdgcn_fence(__ATOMIC_RELEASE, "agent");
      asm volatile("s_waitcnt vmcnt(0)" ::: "memory");
      const unsigned og = xb_add(&bar[XB_TOP], 1u);
      const unsigned tg = og / nx;
      if (og + 1u == (tg + 1u) * nx) xb_add(&bar[XB_TOPGEN], 1u);
      else XB_SPIN(xb_ld(&bar[XB_TOPGEN]) == tg, bar);
      __builtin_amdgcn_fence(__ATOMIC_ACQUIRE, "agent");
      xb_add(&bar[XB_XGEN(b.x)], 1u);
      asm volatile("s_waitcnt vmcnt(0)" ::: "memory");
    } else {
      XB_SPIN(xb_ld(&bar[XB_XGEN(b.x)]) == gen, bar);
      __builtin_amdgcn_fence(__ATOMIC_ACQUIRE, "agent");
      asm volatile("s_waitcnt vmcnt(0)" ::: "memory");
    }
  }
  __syncthreads();
}

__shared__ __attribute__((aligned(16))) char g_smem[SMEM_BYTES];
__shared__ int s_item;

DEVI int next_item(int* ctr) {
  __syncthreads();
  if (threadIdx.x == 0) s_item = atomicAdd(ctr, 1);
  __syncthreads();
  return s_item;
}

struct P1Queue { int* c8; int x0; int d; };
DEVI bool p1_pop(P1Queue& qu, int& mt, int& nt) {
  while (qu.d < 8) {
    const int x = (qu.x0 + qu.d) & 7;
    const int qq = next_item(qu.c8 + x);
    if (qq < 1792) {
      const int st = qq >> 6, within = qq & 63;
      mt = 16 * x + (st & 3) * 4 + (within & 3);
      nt = (st >> 2) * 16 + (within >> 2);
      return true;
    }
    ++qu.d;
  }
  return false;
}

DEVI void p1_phase(const P& p, int gg, int l, int qidx, char* smem) {
  P1Queue qu; qu.c8 = p.f_ctr2() + qidx * 8; qu.x0 = (int)(xb_xcc_id() & 7u); qu.d = 0;
  int mt, nt;
  if (!p1_pop(qu, mt, nt)) return;
  P1Tile cur; p1_desc(p, gg, l, mt, nt, cur);
  const int tid = TID(), lrow = tid >> 3, lkc = (tid & 7) * 8;
  u32x4 ra0[4], rb0[4], ra1[4], rb1[4];
  {
    const unsigned voa = (unsigned)(lrow * (int)cur.rs + lkc) * 2u, vob = (unsigned)(lrow * LDW + lkc) * 2u;
#pragma unroll
    for (int i = 0; i < 4; ++i) {
      ra0[i] = *(const u32x4*)((const char*)(cur.A + (long)(32 * i) * cur.rs) + voa); rb0[i] = *(const u32x4*)((const char*)(cur.B + (long)(32 * i) * LDW) + vob);
    }
#pragma unroll
    for (int i = 0; i < 4; ++i) {
      ra1[i] = *(const u32x4*)((const char*)(cur.A + (long)(32 * i) * cur.rs + 64) + voa); rb1[i] = *(const u32x4*)((const char*)(cur.B + (long)(32 * i) * LDW + 64) + vob);
    }
  }
  for (;;) {
    P1Tile nxt = cur;
    const bool has_next = p1_pop(qu, mt, nt);
    if (has_next) p1_desc(p, gg, l, mt, nt, nxt);
    f32x4 acc[4][4];
    zero_acc(acc);
    if (cur.vt) gemm_stream<false>(cur.A, cur.rs, cur.B, nxt.A, nxt.rs, nxt.B, ra0, rb0, ra1, rb1, acc, (bf16_t*)smem);
    else gemm_stream<true>(cur.A, cur.rs, cur.B, nxt.A, nxt.rs, nxt.B, ra0, rb0, ra1, rb1, acc, (bf16_t*)smem);
    p1_epilogue(p, cur, acc, smem);
    if (!has_next) break;
    cur = nxt;
  }
}

template <int ph>
DEVI void run_pre(const P& p) {
  char* smem = g_smem;
  const int tid = TID(), lane = tid & 63, wid = tid >> 6;
  const int G = gridDim.x, bid = blockIdx.x;
  if (ph == 0) {
    constexpr int N0 = 96, N1 = N0 + 1, N2 = N1 + 256, N3 = N2 + 7168, N4 = N3 + 96, N5 = N4 + 64, N6 = N5 + 1024, N7 = N6 + 512;
    for (int it = bid; it < N7; it += G) {
      if (it < N0) mod_item(p, it, smem);
      else if (it < N1) {
        if (tid < 64) {
          for (int l = 0; l < 2; ++l) {
            const float s1 = wave_sum(p.lq1[l * 64 + lane] * p.lk1[l * 64 + lane]);
            const float s2 = wave_sum(p.lq2[l * 64 + lane] * p.lk2[l * 64 + lane]);
            const float lam_init = 0.8f - 0.6f * expf(-0.3f * (float)l);
            if (lane == 0) p.f_lam()[l] = expf(s1) - expf(s2) + lam_init;
          }
          for (int i = lane; i < 256; i += 64) { p.f_ctr()[i] = 0; p.f_ctr2()[i] = 0; }
        }
      } else if (it < N2) rope_item(p, it - N1);
      else if (it < N3) {
        const int q = it - N2, l = q / 3584, r = q % 3584, nt = r >> 4, kt = r & 15;
        tconv_tile<0>(p.w_in + (long)l * 1024 * 14248, 14248, p.f_wInT() + (long)l * LDY * LDW, LDW, nt * 64, kt * 64, nullptr, (float*)smem);
      } else if (it < N4) {
        const int q = it - N3, l = q / 48, r = q % 48, nt = r >> 2, kt = r & 3;
        tconv_tile<1>(p.w_uq + (long)l * 256 * 768, 768, p.f_wUqT() + (long)l * 768 * 256, 256, nt * 64, kt * 64, p.q_norm_c + l * 256, (float*)smem);
      } else if (it < N5) {
        const int q = it - N4, l = q / 32, r = q % 32, nt = r >> 1, kt = r & 1;
        tconv_tile<2>(p.w_ukv + (long)l * 128 * 1024, 1024, p.f_wUkvT() + (long)l * 1024 * 128, 128, nt * 64, kt * 64, p.kv_norm_c + l * 128, (float*)smem);
      } else if (it < N6) {
        const int q = it - N5, ln = q >> 7, r = q & 127, nt = r >> 3, kt = r & 7;
        tconv_tile<3>(p.w_br + (long)ln * 512 * 1024, 1024, p.f_wBrT() + (long)ln * 1024 * 512, 512, nt * 64, kt * 64, nullptr, (float*)smem);
      } else {
        const int q = it - N6, l = q >> 8, r = q & 255, nt = r >> 4, kt = r & 15;
        tconv_tile<3>(p.w_out + (long)l * 1024 * 1024, 1024, p.f_wOutT() + (long)l * 1024 * 1024, 1024, nt * 64, kt * 64, nullptr, (float*)smem);
      }
    }
    return;
  }
  if (ph == 1) {
    for (int it = bid; it < 65536 / 4; it += G) {
      const long tok = (long)it * 4 + wid;
      float4 v[4];
#pragma unroll
      for (int i = 0; i < 4; ++i) v[i] = *(const float4*)(p.x + tok * 1024 + i * 256 + lane * 4);
      float mu, rstd;
      ln_stats(v, mu, rstd);
      store_h(v, mu, rstd, p.f_mod() + (long)(tok >> 11) * 3072, p.f_h() + tok * LDH, lane);
    }
    return;
  }
}

DEVI void run_phase(const P& p, int ph) {
  char* smem = g_smem;
  const int tid = TID(), lane = tid & 63, wid = tid >> 6;
  const int G = gridDim.x, bid = blockIdx.x;
  const int q = ph - 2, gg = q / 12, l = (q % 12) / 6, k = q % 6;
  int* ctr = p.f_ctr() + (ph & 63);
  if (k == 0) {
    {
      const int x0 = (int)(xb_xcc_id() & 7u);
      int* c8 = p.f_ctr2() + (q / 6) * 8;
      for (int dd = 0; dd < 8; ++dd) {
        const int x = (x0 + dd) & 7;
        for (;;) {
          const int qq = next_item(c8 + x);
          if (qq >= 896) break;
          const int st = qq >> 6, within = qq & 63;
          P1Tile d;
          p1_desc2(p, gg, l, 16 * x + (st & 1) * 8 + (within & 7), (st >> 1) * 8 + (within >> 3), d);
          p1_tile2(p, d, smem);
        }
      }
    }
  } else if (k == 1) {
    constexpr int N0 = 1024, N1 = N0 + 1024, N2 = N1 + 768, N3 = N2 + 3072, N4 = N3 + 128;
    for (;;) {
      const int it = next_item(ctr);
      if (it >= N4) break;
      if (it < N0) b1_item(p, l, it, smem);
      else if (it < N1) { const int t = it - N0; p2_kvup_tile(p, gg, l, t >> 3, t & 7, smem); }
      else if (it < N2) { const int t = it - N1; p2_qup_tile(p, gg, l, t / 6, t % 6, smem); }
      else if (it < N3) attnD_item(p, it - N2, smem);
      else p2_kpe_item(p, gg, it - N3);
    }
  } else if (k == 2) {
    for (;;) {
      const int it = next_item(ctr);
      if (it >= 32) break;
      __builtin_amdgcn_s_setprio(3);
      b2_item(p, l, it, smem);
      __builtin_amdgcn_s_setprio(0);
    }
    {
      const int x0 = (int)(xb_xcc_id() & 7u);
      int* c8 = p.f_ctr2() + 64 + (q / 6) * 8;
      for (int dd = 0; dd < 8; ++dd) {
        const int x = (x0 + dd) & 7;
        for (;;) {
          const int i = next_item(c8 + x);
          if (i >= 256) break;
          if (i < 128) { const int bh = x + 8 * (i >> 5), qt = 31 - (i & 31); attnA_item(p, l, ((31 - qt) << 5) | bh, smem); }
          else { const int i2 = i - 128; const int bh = x + 8 * (i2 >> 4), qt = 15 - (i2 & 15); attnC_item(p, ((15 - qt) << 6) | bh, smem); }
        }
      }
    }
    for (;;) {
      const int it = next_item(ctr + 64);
      if (it >= 128) break;
      dcomb_item(p, it);
    }
  } else if (k == 3) {
    for (int it = bid; it < 1024; it += G) p4a_tile(p, l, it >> 3, it & 7, smem);
  } else if (k == 4) {
    for (int it = bid; it < 1024; it += G) p4b_tile(p, gg, l, it >> 3, it & 7, smem);
  } else {
    for (int it = bid; it < TG / 4; it += G) p4c_row(p, gg, l, (long)gg * TG + (long)it * 4 + wid, lane);
  }
}

__global__ void __launch_bounds__(256, 2) mega(P p, int ph_lo, int ph_hi) {
#if MULTI_LAUNCH
  run_phase(p, ph_lo);
#else
  cg::grid_group grid = cg::this_grid();
  __shared__ uint4 xb_words;
  if (threadIdx.x == 0) xb_words = make_uint4(0u, 0u, 0u, 0u);
  __syncthreads();
  XcdBarrier xb = xcd_barrier_post(p.f_bar(), (volatile LAS unsigned*)&xb_words);
  run_pre<0>(p); xcd_barrier(xb);
  run_pre<1>(p); xcd_barrier(xb);
  for (int ph = ph_lo + 2; ph < ph_hi; ++ph) {
    run_phase(p, ph);
    if (ph + 1 < ph_hi) {
      if (ph_hi < 0) grid.sync();
      if ((ph - 2) % 12 != 11) xcd_barrier(xb);
    }
  }
#endif
}

extern "C" void kernel_launch(void* const* d_in, const int* in_sizes, int n_in, void* d_out, int out_size, void* d_ws, size_t ws_size,
                              hipStream_t stream) {
  P p{};
  p.x = (const float*)d_in[0]; p.c = (const float*)d_in[1]; p.pos = (const int*)d_in[2];
  p.w_ada = (const float*)d_in[3]; p.b_ada = (const float*)d_in[4]; p.w_in = (const float*)d_in[5]; p.conv_b = (const float*)d_in[6];
  p.a_log = (const float*)d_in[7]; p.dt_bias = (const float*)d_in[8]; p.out_norm_b = (const float*)d_in[9];
  p.lq1 = (const float*)d_in[10]; p.lk1 = (const float*)d_in[11]; p.lq2 = (const float*)d_in[12]; p.lk2 = (const float*)d_in[13];
  p.subln_g = (const float*)d_in[14]; p.q_norm_c = (const float*)d_in[15]; p.w_uq = (const float*)d_in[16]; p.kv_norm_c = (const float*)d_in[17];
  p.w_ukv = (const float*)d_in[18]; p.w_br = (const float*)d_in[19]; p.w_out = (const float*)d_in[20]; p.ln_g = (const float*)d_in[21];
  p.ln_b = (const float*)d_in[22];
  p.out = (float*)d_out;
  p.ws = (char*)d_ws;
  if (WS_TOTAL > ws_size) { fprintf(stderr, "workspace too small: need %zu have %zu\n", (size_t)WS_TOTAL, ws_size); return; }
#if MULTI_LAUNCH
  for (int ph = 0; ph < NPHASE; ++ph) hipLaunchKernelGGL(mega, dim3(512), dim3(256), 0, stream, p, ph, ph + 1);
#else
  static int grid_blocks = 0;
  if (!grid_blocks) {
    int dev = 0, cus = 0, per_cu = 0;
    hipGetDevice(&dev);
    hipDeviceGetAttribute(&cus, hipDeviceAttributeMultiprocessorCount, dev);
    hipOccupancyMaxActiveBlocksPerMultiprocessor(&per_cu, mega, 256, 0);
    if (per_cu > 2) per_cu = 2;
    grid_blocks = cus * per_cu;
    grid_blocks &= ~7;
    if (grid_blocks < 8) grid_blocks = 8;
  }
  int lo = 0, hi = NPHASE;
  void* args[] = {&p, &lo, &hi};
  (void)hipMemsetAsync((char*)d_ws + WS_BAR_OFF, 0, XCD_BAR_WORDS * 4, stream);
  hipError_t e = hipLaunchCooperativeKernel((void*)mega, dim3(grid_blocks), dim3(256), args, 0, stream);
  if (e != hipSuccess) fprintf(stderr, "cooperative launch failed: %s (grid %d)\n", hipGetErrorString(e), grid_blocks);
#endif
}
```

```cpp
#include <hip/hip_runtime.h>
#include <hip/hip_cooperative_groups.h>
#include <cstdio>
#include <cstdint>
namespace cg = cooperative_groups;

#ifndef MULTI_LAUNCH
#define MULTI_LAUNCH 0
#endif

typedef unsigned short bf16_t;
typedef short bf16x8 __attribute__((ext_vector_type(8)));
typedef float f32x4 __attribute__((ext_vector_type(4)));
typedef unsigned u32x4 __attribute__((ext_vector_type(4)));
typedef unsigned u32x2 __attribute__((ext_vector_type(2)));

#define DEVI __device__ __forceinline__

constexpr int S_ = 2048, DM = 1024, NBT = 32, NB = 8, NGRP = 4, TG = NB * S_;
constexpr int LDY = 14336;
constexpr int LDH = 1024 + 64, LDW = 1024 + 64;
constexpr int YA_Q = 0, YA_K = 512, YB_Q = 1536, YC = 3072, YKPE = 3456, YBETA = 3488, YDECAY = 3492,
              YD_Q = 3584, YD_K = 5120, YZ = 8192, YMG = 10240;
constexpr float EPS = 1e-6f;
constexpr float LOG2E = 1.4426950408889634f, LN2 = 0.6931471805599453f;
constexpr int SMEM_BYTES = 74240;
constexpr int NPHASE = 2 + NGRP * 2 * 6;

struct P {
  const float *x, *c; const int* pos;
  const float *w_ada, *b_ada, *w_in, *conv_b, *a_log, *dt_bias, *out_norm_b, *lq1, *lk1, *lq2, *lk2, *subln_g,
      *q_norm_c, *w_uq, *kv_norm_c, *w_ukv, *w_br, *w_out, *ln_g, *ln_b;
  float* out;
  char* ws;
  DEVI bf16_t* f_wInT() const { return (bf16_t*)(ws + 0ULL); }
  DEVI bf16_t* f_wUqT() const { return (bf16_t*)(ws + 62390272ULL); }
  DEVI bf16_t* f_wUkvT() const { return (bf16_t*)(ws + 63176704ULL); }
  DEVI bf16_t* f_wBrT() const { return (bf16_t*)(ws + 63700992ULL); }
  DEVI bf16_t* f_wOutT() const { return (bf16_t*)(ws + 72089600ULL); }
  DEVI float* f_mod() const { return (float*)(ws + 76283904ULL); }
  DEVI float2* f_ropeA() const { return (float2*)(ws + 77070336ULL); }
  DEVI float2* f_ropeC() const { return (float2*)(ws + 81264640ULL); }
  DEVI float* f_lam() const { return (float*)(ws + 89653248ULL); }
  DEVI int* f_ctr() const { return (int*)(ws + 89653504ULL); }
  DEVI int* f_ctr2() const { return (int*)(ws + 89654528ULL); }
  DEVI unsigned* f_bar() const { return (unsigned*)(ws + 89655552ULL); }
  DEVI bf16_t* f_h() const { return (bf16_t*)(ws + 89669376ULL); }
  DEVI bf16_t* f_Y() const { return (bf16_t*)(ws + 232275712ULL); }
  DEVI bf16_t* f_AvT() const { return (bf16_t*)(ws + 702037760ULL); }
  DEVI bf16_t* f_DvT() const { return (bf16_t*)(ws + 718814976ULL); }
  DEVI bf16_t* f_Qc() const { return (bf16_t*)(ws + 769146624ULL); }
  DEVI bf16_t* f_Kc() const { return (bf16_t*)(ws + 794312448ULL); }
  DEVI bf16_t* f_CvT() const { return (bf16_t*)(ws + 819478272ULL); }
  DEVI bf16_t* f_Do() const { return (bf16_t*)(ws + 836255488ULL); }
  DEVI float* f_Dlse() const { return (float*)(ws + 886587136ULL); }
  DEVI bf16_t* f_UT() const { return (bf16_t*)(ws + 888160000ULL); }
  DEVI bf16_t* f_Wm() const { return (bf16_t*)(ws + 904937216ULL); }
  DEVI bf16_t* f_QG() const { return (bf16_t*)(ws + 921714432ULL); }
  DEVI bf16_t* f_KGT() const { return (bf16_t*)(ws + 938491648ULL); }
  DEVI bf16_t* f_QKm() const { return (bf16_t*)(ws + 955268864ULL); }
  DEVI float* f_dlast() const { return (float*)(ws + 963657472ULL); }
  DEVI bf16_t* f_br() const { return (bf16_t*)(ws + 963661568ULL); }
  DEVI bf16_t* f_merged() const { return f_Do(); }
};
constexpr size_t WS_TOTAL = 1030770432ULL, WS_BAR_OFF = 89655552ULL;


DEVI int TID() { int t = threadIdx.x; asm volatile("" : "+v"(t)); return t; }
DEVI float bf2f(bf16_t b) { return __uint_as_float(((unsigned)b) << 16); }
DEVI bf16_t f2bf(float f) { unsigned u = __float_as_uint(f); u += 0x7fffu + ((u >> 16) & 1u); return (bf16_t)(u >> 16); }
typedef float f32x2_t __attribute__((ext_vector_type(2)));
typedef __bf16 bf16x2_t __attribute__((ext_vector_type(2)));
DEVI unsigned pk2(float lo, float hi) { f32x2_t v = {lo, hi}; bf16x2_t b = __builtin_convertvector(v, bf16x2_t); return __builtin_bit_cast(unsigned, b); }
DEVI float lo2f(unsigned u) { return __uint_as_float(u << 16); }
DEVI float hi2f(unsigned u) { return __uint_as_float(u & 0xffff0000u); }
DEVI f32x4 mma(bf16x8 a, bf16x8 b, f32x4 c) { return __builtin_amdgcn_mfma_f32_16x16x32_bf16(a, b, c, 0, 0, 0); }
DEVI float sigmf(float x) { return __builtin_amdgcn_rcpf(1.f + __builtin_amdgcn_exp2f(-1.4426950408889634f * x)); }
DEVI float siluf(float x) { return x * sigmf(x); }
DEVI float ex2(float x) { return __builtin_amdgcn_exp2f(x); }
DEVI bf16x8 ldfrag(const bf16_t* p) { return *(const bf16x8*)p; }

template <bool SWAP, int NT = 4>
DEVI void gemm_core(const bf16_t* __restrict__ A, long rs, const bf16_t* __restrict__ B, long ldb, int K,
                    f32x4 (&acc)[4][NT], bf16_t* sm) {
  const int tid = TID(), lane = tid & 63, wid = tid >> 6, g = lane >> 4, lr = lane & 15;
  const int wm = wid >> 1, wn = wid & 1;
  const int lrow = tid >> 3, lkc = (tid & 7) * 8;
  const int wsw = ((tid & 7) ^ ((lrow >> 1) & 7)) * 8;
  bf16_t* sA = sm; bf16_t* sB = sm + 2 * 128 * 64;
  const bf16_t* ap = A + (long)lrow * rs + lkc;
  const bf16_t* bp = B + (long)lrow * ldb + lkc;
  u32x4 ra0[4], rb0[NT], ra1[4], rb1[NT];
  const int nk = K >> 6;
#pragma unroll
  for (int i = 0; i < 4; ++i) ra0[i] = *(const u32x4*)(ap + (long)(32 * i) * rs);
#pragma unroll
  for (int i = 0; i < NT; ++i) rb0[i] = *(const u32x4*)(bp + (long)(32 * i) * ldb);
#pragma unroll
  for (int i = 0; i < 4; ++i) ra1[i] = *(const u32x4*)(ap + (long)(32 * i) * rs + 64);
#pragma unroll
  for (int i = 0; i < NT; ++i) rb1[i] = *(const u32x4*)(bp + (long)(32 * i) * ldb + 64);
#pragma unroll
  for (int i = 0; i < 4; ++i) *(u32x4*)&sA[(lrow + 32 * i) * 64 + wsw] = ra0[i];
#pragma unroll
  for (int i = 0; i < NT; ++i) *(u32x4*)&sB[(lrow + 32 * i) * 64 + wsw] = rb0[i];
  __syncthreads();
  const int f = (lr >> 1) & 7;
  const int rsw0 = (g ^ f) * 8, rsw1 = ((4 + g) ^ f) * 8;
  const bf16_t* cA0 = sA + (wm * 64 + lr) * 64;
  const bf16_t* cB0 = sB + (wn * NT * 16 + lr) * 64;
  auto compute = [&](int cur) {
    const bf16_t* cA = cA0 + cur * 128 * 64;
    const bf16_t* cB = cB0 + cur * 128 * 64;
#pragma unroll
    for (int ks = 0; ks < 2; ++ks) {
      const int rsw = ks ? rsw1 : rsw0;
      bf16x8 af[4];
#pragma unroll
      for (int t = 0; t < 4; ++t) af[t] = ldfrag(cA + t * 16 * 64 + rsw);
#pragma unroll
      for (int nt = 0; nt < NT; ++nt) {
        const bf16x8 bfr = ldfrag(cB + nt * 16 * 64 + rsw);
#pragma unroll
        for (int mt = 0; mt < 4; ++mt) {
          if (SWAP) acc[mt][nt] = mma(bfr, af[mt], acc[mt][nt]);
          else acc[mt][nt] = mma(af[mt], bfr, acc[mt][nt]);
        }
      }
    }
  };
  for (int kt = 0; kt < nk; kt += 2) {
    {
      const int kn = (kt + 2 < nk ? kt + 2 : nk - 1) * 64;
#pragma unroll
      for (int i = 0; i < 4; ++i) ra0[i] = *(const u32x4*)(ap + (long)(32 * i) * rs + kn);
#pragma unroll
      for (int i = 0; i < NT; ++i) rb0[i] = *(const u32x4*)(bp + (long)(32 * i) * ldb + kn);
    }
    compute(0);
    {
      bf16_t* nA = sA + 128 * 64; bf16_t* nB = sB + 128 * 64;
#pragma unroll
      for (int i = 0; i < 4; ++i) *(u32x4*)&nA[(lrow + 32 * i) * 64 + wsw] = ra1[i];
#pragma unroll
      for (int i = 0; i < NT; ++i) *(u32x4*)&nB[(lrow + 32 * i) * 64 + wsw] = rb1[i];
    }
    __syncthreads();
    {
      const int kn = (kt + 3 < nk ? kt + 3 : nk - 1) * 64;
#pragma unroll
      for (int i = 0; i < 4; ++i) ra1[i] = *(const u32x4*)(ap + (long)(32 * i) * rs + kn);
#pragma unroll
      for (int i = 0; i < NT; ++i) rb1[i] = *(const u32x4*)(bp + (long)(32 * i) * ldb + kn);
    }
    compute(1);
    if (kt + 2 < nk) {
#pragma unroll
      for (int i = 0; i < 4; ++i) *(u32x4*)&sA[(lrow + 32 * i) * 64 + wsw] = ra0[i];
#pragma unroll
      for (int i = 0; i < NT; ++i) *(u32x4*)&sB[(lrow + 32 * i) * 64 + wsw] = rb0[i];
    }
    __syncthreads();
  }
}

template <int NT>
DEVI void zero_acc(f32x4 (&acc)[4][NT]) {
#pragma unroll
  for (int i = 0; i < 4; ++i)
#pragma unroll
    for (int j = 0; j < NT; ++j) acc[i][j] = (f32x4){0.f, 0.f, 0.f, 0.f};
}

DEVI int src_col_win(int n) {
  if (n < 3072) return n;
  if (n < 3488) return 3080 + (n - 3072);
  if (n < 3496) return 3072 + (n - 3488);
  if (n < 3584) return -1;
  if (n < 8192) return 3496 + (n - 3584);
  if (n < 10240) return 8104 + (n - 8192);
  return 10152 + (n - 10240);
}

template <int MODE>
DEVI void tconv_tile(const float* __restrict__ src, int ldsrc, bf16_t* __restrict__ dst, int K, int n0, int k0,
                     const float* __restrict__ kscale, float* t) {
  const int tid = TID();
  const int kk = tid >> 4, nn = (tid & 15) * 4;
  const int n = n0 + nn;
  int sc;
  if (MODE == 0) sc = src_col_win(n);
  else if (MODE == 2) sc = (n < 512) ? ((n >> 6) * 128 + (n & 63)) : (((n - 512) >> 6) * 128 + 64 + ((n - 512) & 63));
  else sc = n;
#pragma unroll
  for (int i = 0; i < 4; ++i) {
    const int k = kk + 16 * i;
    float4 v = make_float4(0.f, 0.f, 0.f, 0.f);
    if (sc >= 0) v = *(const float4*)(src + (long)(k0 + k) * ldsrc + sc);
    if (kscale) { const float s = kscale[k0 + k]; v.x *= s; v.y *= s; v.z *= s; v.w *= s; }
    t[k * 65 + nn + 0] = v.x; t[k * 65 + nn + 1] = v.y; t[k * 65 + nn + 2] = v.z; t[k * 65 + nn + 3] = v.w;
  }
  __syncthreads();
  const int n2 = tid >> 2, kq = (tid & 3) * 16;
  u32x4 o0, o1;
  o0.x = pk2(t[(kq + 0) * 65 + n2], t[(kq + 1) * 65 + n2]); o0.y = pk2(t[(kq + 2) * 65 + n2], t[(kq + 3) * 65 + n2]);
  o0.z = pk2(t[(kq + 4) * 65 + n2], t[(kq + 5) * 65 + n2]); o0.w = pk2(t[(kq + 6) * 65 + n2], t[(kq + 7) * 65 + n2]);
  o1.x = pk2(t[(kq + 8) * 65 + n2], t[(kq + 9) * 65 + n2]); o1.y = pk2(t[(kq + 10) * 65 + n2], t[(kq + 11) * 65 + n2]);
  o1.z = pk2(t[(kq + 12) * 65 + n2], t[(kq + 13) * 65 + n2]); o1.w = pk2(t[(kq + 14) * 65 + n2], t[(kq + 15) * 65 + n2]);
  bf16_t* d = dst + (long)(n0 + n2) * K + k0 + kq;
  *(u32x4*)d = o0; *(u32x4*)(d + 8) = o1;
  __syncthreads();
}

DEVI void mod_item(const P& p, int item, char* smem) {
  const int l = item / 48, j0 = (item % 48) * 64;
  const int tid = TID(), kq = tid >> 6, j = tid & 63;
  float* cs = (float*)smem;
  float* red = cs + 4096;
  float acc[32];
#pragma unroll
  for (int b = 0; b < 32; ++b) acc[b] = 0.f;
  const float* w = p.w_ada + (long)l * 1024 * 3072 + j0 + j;
  for (int ch = 0; ch < 8; ++ch) {
#pragma unroll
    for (int i = 0; i < 16; ++i) {
      const int idx = tid + 256 * i;
      const int q = idx >> 10, b = (idx >> 5) & 31, kk = idx & 31;
      const float cv = p.c[b * 1024 + q * 256 + ch * 32 + kk];
      cs[idx] = siluf(cv);
    }
    __syncthreads();
#pragma unroll 1
    for (int kk4 = 0; kk4 < 8; ++kk4) {
      const int kb = kq * 256 + ch * 32 + kk4 * 4;
      const float w0 = w[(long)(kb + 0) * 3072], w1 = w[(long)(kb + 1) * 3072], w2 = w[(long)(kb + 2) * 3072], w3 = w[(long)(kb + 3) * 3072];
#pragma unroll
      for (int b = 0; b < 32; ++b) {
        const float4 cv = *(const float4*)&cs[(kq * 32 + b) * 32 + kk4 * 4];
        acc[b] += cv.x * w0 + cv.y * w1 + cv.z * w2 + cv.w * w3;
      }
    }
    __syncthreads();
  }
#pragma unroll
  for (int b = 0; b < 32; ++b) red[(kq * 32 + b) * 64 + j] = acc[b];
  __syncthreads();
#pragma unroll
  for (int i = 0; i < 8; ++i) {
    const int idx = tid + 256 * i;
    const int b = idx >> 6, jj = idx & 63;
    const float v = red[(0 * 32 + b) * 64 + jj] + red[(1 * 32 + b) * 64 + jj] + red[(2 * 32 + b) * 64 + jj] + red[(3 * 32 + b) * 64 + jj] +
                    p.b_ada[l * 3072 + j0 + jj];
    p.f_mod()[(long)(l * 32 + b) * 3072 + j0 + jj] = v;
  }
  __syncthreads();
}

DEVI void rope_item(const P& p, int item) {
  const int t = item * 256 + TID();
  const float pos = (float)p.pos[t];
  const double L2T = 18.931568569324174;
  const double INV2PI = 0.15915494309189535;
#pragma unroll
  for (int i = 0; i < 8; ++i) {
    const float invf = (float)exp2(-(double)i * L2T / 8.0);
    const float ang = pos * invf;
    const double rev = (double)ang * INV2PI;
    const float fr = (float)(rev - floor(rev));
    p.f_ropeA()[(long)t * 8 + i] = make_float2(__builtin_amdgcn_cosf(fr), __builtin_amdgcn_sinf(fr));
  }
#pragma unroll
  for (int i = 0; i < 16; ++i) {
    const float invf = (float)exp2(-(double)i * L2T / 16.0);
    const float ang = pos * invf;
    const double rev = (double)ang * INV2PI;
    const float fr = (float)(rev - floor(rev));
    p.f_ropeC()[(long)t * 16 + i] = make_float2(__builtin_amdgcn_cosf(fr), __builtin_amdgcn_sinf(fr));
  }
}

DEVI float wave_sum(float v) {
#pragma unroll
  for (int o = 32; o >= 1; o >>= 1) v += __shfl_xor(v, o);
  return v;
}

DEVI void ln_stats(const float4 (&v)[4], float& mu, float& rstd) {
  float s = 0.f;
#pragma unroll
  for (int i = 0; i < 4; ++i) s += (v[i].x + v[i].y) + (v[i].z + v[i].w);
  mu = wave_sum(s) * (1.f / 1024.f);
  float q = 0.f;
#pragma unroll
  for (int i = 0; i < 4; ++i) { const float a = v[i].x - mu, b = v[i].y - mu, c = v[i].z - mu, d = v[i].w - mu; q += (a * a + b * b) + (c * c + d * d); }
  rstd = rsqrtf(wave_sum(q) * (1.f / 1024.f) + EPS);
}

DEVI void store_h(const float4 (&v)[4], float mu, float rstd, const float* __restrict__ modb, bf16_t* __restrict__ hr, int lane) {
#pragma unroll
  for (int i = 0; i < 4; ++i) {
    const int col = i * 256 + lane * 4;
    const float4 sh = *(const float4*)(modb + col), sc = *(const float4*)(modb + 1024 + col);
    const float a = (v[i].x - mu) * rstd * (1.f + sc.x) + sh.x, b = (v[i].y - mu) * rstd * (1.f + sc.y) + sh.y;
    const float c = (v[i].z - mu) * rstd * (1.f + sc.z) + sh.z, d = (v[i].w - mu) * rstd * (1.f + sc.w) + sh.w;
    u32x2 o; o.x = pk2(a, b); o.y = pk2(c, d);
    *(u32x2*)(hr + col) = o;
  }
}

struct P1Tile { const bf16_t* A; long rs; const bf16_t* B; long tokbase; int bl, j, n0, gi, dl, res, ib; bool vt; };

DEVI void p1_desc(const P& p, int gg, int l, int mtile, int ntile, P1Tile& d) {
  d.bl = mtile >> 4; d.j = mtile & 15; d.n0 = ntile * 128;
  const bool segD = (d.n0 >= 3584 && d.n0 < 8192);
  d.dl = 1; d.gi = 0;
  if (segD) { d.gi = ((d.n0 - 3584) % 1536) / 512; d.dl = d.gi == 0 ? 1 : (d.gi == 1 ? 4 : 16); }
  const int nrb = 16 / d.dl;
  d.res = d.j / nrb; d.ib = d.j % nrb;
  d.tokbase = (long)gg * TG + d.bl * 2048;
  d.A = p.f_h() + (d.tokbase + (long)d.ib * 128 * d.dl + d.res) * LDH;
  d.rs = (long)d.dl * LDH;
  d.B = p.f_wInT() + ((long)l * LDY + d.n0) * LDW;
  d.vt = (d.n0 >= 1024 && d.n0 < 1536) || (d.n0 >= 6656 && d.n0 < 8192);
}

template <bool SWAP>
DEVI void gemm_stream(const bf16_t* __restrict__ ap, long rs, const bf16_t* __restrict__ bp,
                      const bf16_t* __restrict__ nap, long nrs, const bf16_t* __restrict__ nbp,
                      u32x4 (&ra0)[4], u32x4 (&rb0)[4], u32x4 (&ra1)[4], u32x4 (&rb1)[4], f32x4 (&acc)[4][4], bf16_t* sm) {
  const int tid = TID(), lane = tid & 63, wid = tid >> 6, g = lane >> 4, lr = lane & 15;
  const int wm = wid >> 1, wn = wid & 1;
  const int lrow = tid >> 3, lkc = (tid & 7) * 8;
  const int wsw = ((tid & 7) ^ ((lrow >> 1) & 7)) * 8;
  const unsigned voa = (unsigned)(lrow * (int)rs + lkc) * 2u, vona = (unsigned)(lrow * (int)nrs + lkc) * 2u, vob = (unsigned)(lrow * LDW + lkc) * 2u;
  bf16_t* sA = sm; bf16_t* sB = sm + 2 * 128 * 64;
#pragma unroll
  for (int i = 0; i < 4; ++i) *(u32x4*)&sA[(lrow + 32 * i) * 64 + wsw] = ra0[i];
#pragma unroll
  for (int i = 0; i < 4; ++i) *(u32x4*)&sB[(lrow + 32 * i) * 64 + wsw] = rb0[i];
  __syncthreads();
  const int f = (lr >> 1) & 7;
  const int rsw0 = (g ^ f) * 8, rsw1 = ((4 + g) ^ f) * 8;
  const bf16_t* cA0 = sA + (wm * 64 + lr) * 64;
  const bf16_t* cB0 = sB + (wn * 64 + lr) * 64;
  auto compute = [&](int cur) {
    const bf16_t* cA = cA0 + cur * 128 * 64;
    const bf16_t* cB = cB0 + cur * 128 * 64;
#pragma unroll
    for (int ks = 0; ks < 2; ++ks) {
      const int rsw = ks ? rsw1 : rsw0;
      bf16x8 af[4];
#pragma unroll
      for (int t = 0; t < 4; ++t) af[t] = ldfrag(cA + t * 16 * 64 + rsw);
#pragma unroll
      for (int nt = 0; nt < 4; ++nt) {
        const bf16x8 bfr = ldfrag(cB + nt * 16 * 64 + rsw);
#pragma unroll
        for (int mt = 0; mt < 4; ++mt) {
          if (SWAP) acc[mt][nt] = mma(bfr, af[mt], acc[mt][nt]);
          else acc[mt][nt] = mma(af[mt], bfr, acc[mt][nt]);
        }
      }
    }
  };
#pragma unroll 1
  for (int kt = 0; kt < 16; kt += 2) {
    {
      const bool tail = (kt + 2 >= 16);
      const bf16_t* a_ = tail ? nap : ap + (kt + 2) * 64;
      const bf16_t* b_ = tail ? nbp : bp + (kt + 2) * 64;
      const long rs_ = tail ? nrs : rs;
      const unsigned va_ = tail ? vona : voa;
#pragma unroll
      for (int i = 0; i < 4; ++i) ra0[i] = *(const u32x4*)((const char*)(a_ + (long)(32 * i) * rs_) + va_);
#pragma unroll
      for (int i = 0; i < 4; ++i) rb0[i] = *(const u32x4*)((const char*)(b_ + (long)(32 * i) * LDW) + vob);
    }
    compute(0);
    {
      bf16_t* nA = sA + 128 * 64; bf16_t* nB = sB + 128 * 64;
#pragma unroll
      for (int i = 0; i < 4; ++i) *(u32x4*)&nA[(lrow + 32 * i) * 64 + wsw] = ra1[i];
#pragma unroll
      for (int i = 0; i < 4; ++i) *(u32x4*)&nB[(lrow + 32 * i) * 64 + wsw] = rb1[i];
    }
    __syncthreads();
    {
      const bool tail = (kt + 3 >= 16);
      const bf16_t* a_ = tail ? nap + 64 : ap + (kt + 3) * 64;
      const bf16_t* b_ = tail ? nbp + 64 : bp + (kt + 3) * 64;
      const long rs_ = tail ? nrs : rs;
      const unsigned va_ = tail ? vona : voa;
#pragma unroll
      for (int i = 0; i < 4; ++i) ra1[i] = *(const u32x4*)((const char*)(a_ + (long)(32 * i) * rs_) + va_);
#pragma unroll
      for (int i = 0; i < 4; ++i) rb1[i] = *(const u32x4*)((const char*)(b_ + (long)(32 * i) * LDW) + vob);
    }
    compute(1);
    if (kt + 2 < 16) {
#pragma unroll
      for (int i = 0; i < 4; ++i) *(u32x4*)&sA[(lrow + 32 * i) * 64 + wsw] = ra0[i];
#pragma unroll
      for (int i = 0; i < 4; ++i) *(u32x4*)&sB[(lrow + 32 * i) * 64 + wsw] = rb0[i];
    }
    __syncthreads();
  }
}

DEVI void p1_epilogue(const P& p, const P1Tile& d, f32x4 (&acc)[4][4], char* smem) {
  const int tid = TID(), lane = tid & 63, wid = tid >> 6, g = lane >> 4, lr = lane & 15;
  const int wm = wid >> 1, wn = wid & 1;
  const int bl = d.bl, j = d.j, n0 = d.n0, gi = d.gi, dl = d.dl, res = d.res, ib = d.ib;
  const long tokbase = d.tokbase;
  bf16_t* T = (bf16_t*)smem;
  if (d.vt) {
#pragma unroll
    for (int mt = 0; mt < 4; ++mt)
#pragma unroll
      for (int nt = 0; nt < 4; ++nt) {
        const int i0 = wm * 64 + mt * 16 + g * 4;
        const int nl = wn * 64 + nt * 16 + lr;
        u32x2 o; o.x = pk2(acc[mt][nt][0], acc[mt][nt][1]); o.y = pk2(acc[mt][nt][2], acc[mt][nt][3]);
        *(u32x2*)&T[nl * 136 + i0] = o;
      }
    __syncthreads();
#pragma unroll 2
    for (int i = 0; i < 8; ++i) {
      const int c = tid + 256 * i, row = c >> 4, cc = c & 15;
      const u32x4 v = *(const u32x4*)&T[row * 136 + cc * 8];
      const int n = n0 + row;
      bf16_t* dst;
      if (n0 < 1536) { const int cs = n - 1024; dst = p.f_AvT() + ((long)((bl * 4 + (cs >> 7)) * 128 + (cs & 127))) * 2048; }
      else { const int cs = n - 6656 - gi * 512; dst = p.f_DvT() + ((long)(((gi * 8 + bl) * 8 + (cs >> 6)) * 64 + (cs & 63))) * 2048; }
      __builtin_nontemporal_store(v, (u32x4*)(dst + j * 128 + cc * 8));
    }
    __syncthreads();
  } else {
    const bool rope = (n0 < 1024) || (n0 >= 3584 && n0 < 6656);
    const bool sg = (n0 >= YMG);
#pragma unroll
    for (int mt = 0; mt < 4; ++mt) {
      const int i = wm * 64 + mt * 16 + lr;
      const int s = (ib * 128 + i) * dl + res;
#pragma unroll
      for (int nt = 0; nt < 4; ++nt) {
        f32x4 v = acc[mt][nt];
        if (nt == 0 && rope) {
          const float2* tb = p.f_ropeA() + (tokbase + s) * 8 + (g & 1) * 4;
#pragma unroll
          for (int r = 0; r < 4; ++r) {
            const float pv = __shfl_xor(v[r], 32);
            const float2 cs = tb[r];
            v[r] = (g < 2) ? (v[r] * cs.x - pv * cs.y) : (v[r] * cs.x + pv * cs.y);
          }
        }
        if (sg) {
#pragma unroll
          for (int r = 0; r < 4; ++r) v[r] = sigmf(v[r]);
        }
        u32x2 o; o.x = pk2(v[0], v[1]); o.y = pk2(v[2], v[3]);
        *(u32x2*)&T[i * 136 + wn * 64 + nt * 16 + g * 4] = o;
      }
    }
    __syncthreads();
    bf16_t* ybase = p.f_Y() + ((long)(bl * 2048 + j * 128)) * LDY + n0;
#pragma unroll 2
    for (int i = 0; i < 8; ++i) {
      const int c = tid + 256 * i, row = c >> 4, cc = c & 15;
      __builtin_nontemporal_store(*(const u32x4*)&T[row * 136 + cc * 8], (u32x4*)(ybase + (long)row * LDY + cc * 8));
    }
    __syncthreads();
  }
}


template <bool SWAP>
DEVI void gemm_big(const bf16_t* __restrict__ A, long rs, const bf16_t* __restrict__ B, f32x4 (&acc)[4][8], bf16_t* sm) {
  const int tid = TID(), lane = tid & 63, wid = tid >> 6, g = lane >> 4, lr = lane & 15;
  const int wm = wid >> 1, wn = wid & 1;
  const int lrow = tid >> 3, lkc = (tid & 7) * 8;
  const int wsw = ((tid & 7) ^ ((lrow >> 1) & 7)) * 8;
  const unsigned voa = (unsigned)(lrow * (int)rs + lkc) * 2u, vob = (unsigned)(lrow * LDW + lkc) * 2u;
  bf16_t* sA = sm; bf16_t* sB = sm + 128 * 64;
  u32x4 ra[4], rb[8];
#pragma unroll
  for (int i = 0; i < 4; ++i) ra[i] = *(const u32x4*)((const char*)(A + (long)(32 * i) * rs) + voa);
#pragma unroll
  for (int i = 0; i < 8; ++i) rb[i] = *(const u32x4*)((const char*)(B + (long)(32 * i) * LDW) + vob);
  const int f = (lr >> 1) & 7;
  const int rsw0 = (g ^ f) * 8, rsw1 = ((4 + g) ^ f) * 8;
  const bf16_t* cA = sA + (wm * 64 + lr) * 64;
  const bf16_t* cB = sB + (wn * 128 + lr) * 64;
#pragma unroll 1
  for (int kt = 0; kt < 16; ++kt) {
#pragma unroll
    for (int i = 0; i < 4; ++i) *(u32x4*)&sA[(lrow + 32 * i) * 64 + wsw] = ra[i];
#pragma unroll
    for (int i = 0; i < 8; ++i) *(u32x4*)&sB[(lrow + 32 * i) * 64 + wsw] = rb[i];
    __syncthreads();
    {
      const int kn = (kt + 1 < 16 ? kt + 1 : 15) * 64;
#pragma unroll
      for (int i = 0; i < 4; ++i) ra[i] = *(const u32x4*)((const char*)(A + (long)(32 * i) * rs + kn) + voa);
#pragma unroll
      for (int i = 0; i < 8; ++i) rb[i] = *(const u32x4*)((const char*)(B + (long)(32 * i) * LDW + kn) + vob);
    }
#pragma unroll
    for (int ks = 0; ks < 2; ++ks) {
      const int rsw = ks ? rsw1 : rsw0;
      bf16x8 af[4];
#pragma unroll
      for (int t = 0; t < 4; ++t) af[t] = ldfrag(cA + t * 16 * 64 + rsw);
#pragma unroll
      for (int nt = 0; nt < 8; ++nt) {
        const bf16x8 bfr = ldfrag(cB + nt * 16 * 64 + rsw);
#pragma unroll
        for (int mt = 0; mt < 4; ++mt) {
          if (SWAP) acc[mt][nt] = mma(bfr, af[mt], acc[mt][nt]);
          else acc[mt][nt] = mma(af[mt], bfr, acc[mt][nt]);
        }
      }
    }
    __syncthreads();
  }
}

DEVI void p1_desc2(const P& p, int gg, int l, int mtile, int ntile, P1Tile& d) {
  d.bl = mtile >> 4; d.j = mtile & 15; d.n0 = ntile * 256;
  const bool segD = (d.n0 >= 3584 && d.n0 < 8192);
  d.dl = 1; d.gi = 0;
  if (segD) { d.gi = ((d.n0 - 3584) % 1536) / 512; d.dl = d.gi == 0 ? 1 : (d.gi == 1 ? 4 : 16); }
  const int nrb = 16 / d.dl;
  d.res = d.j / nrb; d.ib = d.j % nrb;
  d.tokbase = (long)gg * TG + d.bl * 2048;
  d.A = p.f_h() + (d.tokbase + (long)d.ib * 128 * d.dl + d.res) * LDH;
  d.rs = (long)d.dl * LDH;
  d.B = p.f_wInT() + ((long)l * LDY + d.n0) * LDW;
  d.vt = (d.n0 >= 1024 && d.n0 < 1536) || (d.n0 >= 6656 && d.n0 < 8192);
}

DEVI void p1_tile2(const P& p, const P1Tile& d, char* smem) {
  const int tid = TID(), lane = tid & 63, wid = tid >> 6, g = lane >> 4, lr = lane & 15;
  const int wm = wid >> 1, wn = wid & 1;
  const int bl = d.bl, j = d.j, n0 = d.n0, gi = d.gi, dl = d.dl, res = d.res, ib = d.ib;
  const long tokbase = d.tokbase;
  bf16_t* T = (bf16_t*)smem;
  f32x4 acc[4][8];
#pragma unroll
  for (int a = 0; a < 4; ++a)
#pragma unroll
    for (int b = 0; b < 8; ++b) acc[a][b] = (f32x4){0.f, 0.f, 0.f, 0.f};
  if (d.vt) {
    gemm_big<false>(d.A, d.rs, d.B, acc, (bf16_t*)smem);
#pragma unroll
    for (int mt = 0; mt < 4; ++mt)
#pragma unroll
      for (int nt = 0; nt < 8; ++nt) {
        const int i0 = wm * 64 + mt * 16 + g * 4;
        const int nl = wn * 128 + nt * 16 + lr;
        u32x2 o; o.x = pk2(acc[mt][nt][0], acc[mt][nt][1]); o.y = pk2(acc[mt][nt][2], acc[mt][nt][3]);
        *(u32x2*)&T[nl * 136 + i0] = o;
      }
    __syncthreads();
#pragma unroll 2
    for (int i = 0; i < 16; ++i) {
      const int c = tid + 256 * i, row = c >> 4, cc = c & 15;
      const u32x4 v = *(const u32x4*)&T[row * 136 + cc * 8];
      const int n = n0 + row;
      bf16_t* dst;
      if (n0 < 1536) { const int cs = n - 1024; dst = p.f_AvT() + ((long)((bl * 4 + (cs >> 7)) * 128 + (cs & 127))) * 2048; }
      else { const int cs = n - 6656 - gi * 512; dst = p.f_DvT() + ((long)(((gi * 8 + bl) * 8 + (cs >> 6)) * 64 + (cs & 63))) * 2048; }
      __builtin_nontemporal_store(v, (u32x4*)(dst + j * 128 + cc * 8));
    }
    __syncthreads();
  } else {
    gemm_big<true>(d.A, d.rs, d.B, acc, (bf16_t*)smem);
    const bool rope = (n0 < 1024) || (n0 >= 3584 && n0 < 6656);
    const bool sg = (n0 >= YMG);
#pragma unroll
    for (int mt = 0; mt < 4; ++mt) {
      const int i = wm * 64 + mt * 16 + lr;
      const int s = (ib * 128 + i) * dl + res;
#pragma unroll
      for (int nt = 0; nt < 8; ++nt) {
        f32x4 v = acc[mt][nt];
        if ((nt & 3) == 0 && rope) {
          const float2* tb = p.f_ropeA() + (tokbase + s) * 8 + (g & 1) * 4;
#pragma unroll
          for (int r = 0; r < 4; ++r) {
            const float pv = __shfl_xor(v[r], 32);
            const float2 cs = tb[r];
            v[r] = (g < 2) ? (v[r] * cs.x - pv * cs.y) : (v[r] * cs.x + pv * cs.y);
          }
        }
        if (sg) {
#pragma unroll
          for (int r = 0; r < 4; ++r) v[r] = sigmf(v[r]);
        }
        u32x2 o; o.x = pk2(v[0], v[1]); o.y = pk2(v[2], v[3]);
        *(u32x2*)&T[i * 264 + wn * 128 + nt * 16 + g * 4] = o;
      }
    }
    __syncthreads();
    bf16_t* ybase = p.f_Y() + ((long)(bl * 2048 + j * 128)) * LDY + n0;
#pragma unroll 2
    for (int i = 0; i < 16; ++i) {
      const int c = tid + 256 * i, row = c >> 5, cc = c & 31;
      __builtin_nontemporal_store(*(const u32x4*)&T[row * 264 + cc * 8], (u32x4*)(ybase + (long)row * LDY + cc * 8));
    }
    __syncthreads();
  }
}

DEVI void rowscale_prepass(const bf16_t* __restrict__ A, long rs, int K, float* rsl) {
  const int tid = TID(), row = tid >> 1, half = tid & 1;
  const bf16_t* ap = A + (long)row * rs + half * (K >> 1);
  float ss = 0.f;
  for (int c = 0; c < (K >> 4); ++c) {
    const u32x4 u = *(const u32x4*)(ap + c * 8);
    ss += lo2f(u.x) * lo2f(u.x) + hi2f(u.x) * hi2f(u.x) + lo2f(u.y) * lo2f(u.y) + hi2f(u.y) * hi2f(u.y) +
          lo2f(u.z) * lo2f(u.z) + hi2f(u.z) * hi2f(u.z) + lo2f(u.w) * lo2f(u.w) + hi2f(u.w) * hi2f(u.w);
  }
  ss += __shfl_xor(ss, 1);
  if (half == 0) rsl[row] = rsqrtf(ss / (float)K + EPS);
  __syncthreads();
}

DEVI void p2_qup_tile(const P& p, int gg, int l, int mtile, int ntile, char* smem) {
  const int tid = TID(), lane = tid & 63, wid = tid >> 6, g = lane >> 4, lr = lane & 15;
  const int wm = wid >> 1, wn = wid & 1;
  float* rsl = (float*)(smem + 73728);
  const bf16_t* A = p.f_Y() + (long)(mtile * 128) * LDY + YC;
  rowscale_prepass(A, LDY, 256, rsl);
  f32x4 acc[4][4];
  zero_acc(acc);
  gemm_core<true>(A, LDY, p.f_wUqT() + ((long)l * 768 + ntile * 128) * 256, 256, 256, acc, (bf16_t*)smem);
#pragma unroll
  for (int mt = 0; mt < 4; ++mt) {
    const int i = wm * 64 + mt * 16 + lr;
    const int tokl = mtile * 128 + i;
    const float rsv = rsl[i];
    const float2* tb = p.f_ropeC() + ((long)gg * TG + tokl) * 16 + g * 4;
#pragma unroll
    for (int nt = 0; nt < 4; ++nt) {
      const int colb = ntile * 128 + wn * 64 + nt * 16;
      const int cc = colb % 96;
      f32x4 v = acc[mt][nt] * rsv;
      if (cc == 64) {
        const f32x4 pv = acc[mt][(nt + 1) & 3] * rsv;
#pragma unroll
        for (int r = 0; r < 4; ++r) { const float2 cs = tb[r]; v[r] = v[r] * cs.x - pv[r] * cs.y; }
      } else if (cc == 80) {
        const f32x4 pv = acc[mt][(nt + 3) & 3] * rsv;
#pragma unroll
        for (int r = 0; r < 4; ++r) { const float2 cs = tb[r]; v[r] = v[r] * cs.x + pv[r] * cs.y; }
      }
      u32x2 o; o.x = pk2(v[0], v[1]); o.y = pk2(v[2], v[3]);
      *(u32x2*)(p.f_Qc() + (long)tokl * 768 + colb + g * 4) = o;
    }
  }
  __syncthreads();
}

DEVI void p2_kvup_tile(const P& p, int gg, int l, int mtile, int ntile, char* smem) {
  const int tid = TID(), lane = tid & 63, wid = tid >> 6, g = lane >> 4, lr = lane & 15;
  const int wm = wid >> 1, wn = wid & 1;
  float* rsl = (float*)(smem + 73728);
  const bf16_t* A = p.f_Y() + (long)(mtile * 128) * LDY + YC + 256;
  rowscale_prepass(A, LDY, 128, rsl);
  f32x4 acc[4][4];
  zero_acc(acc);
  const bf16_t* B = p.f_wUkvT() + ((long)l * 1024 + ntile * 128) * 128;
  if (ntile < 4) {
    gemm_core<true>(A, LDY, B, 128, 128, acc, (bf16_t*)smem);
#pragma unroll
    for (int mt = 0; mt < 4; ++mt) {
      const int i = wm * 64 + mt * 16 + lr;
      const int tokl = mtile * 128 + i;
      const float rsv = rsl[i];
#pragma unroll
      for (int nt = 0; nt < 4; ++nt) {
        const int n = ntile * 128 + wn * 64 + nt * 16 + g * 4;
        const f32x4 v = acc[mt][nt] * rsv;
        u32x2 o; o.x = pk2(v[0], v[1]); o.y = pk2(v[2], v[3]);
        *(u32x2*)(p.f_Kc() + (long)tokl * 768 + (n >> 6) * 96 + (n & 63)) = o;
      }
    }
  } else {
    gemm_core<false>(A, LDY, B, 128, 128, acc, (bf16_t*)smem);
    const int bl = mtile >> 4, j = mtile & 15;
#pragma unroll
    for (int mt = 0; mt < 4; ++mt) {
      const int i0 = wm * 64 + mt * 16 + g * 4;
      const float r0 = rsl[i0], r1 = rsl[i0 + 1], r2 = rsl[i0 + 2], r3 = rsl[i0 + 3];
#pragma unroll
      for (int nt = 0; nt < 4; ++nt) {
        const int n = (ntile - 4) * 128 + wn * 64 + nt * 16 + lr;
        u32x2 o; o.x = pk2(acc[mt][nt][0] * r0, acc[mt][nt][1] * r1); o.y = pk2(acc[mt][nt][2] * r2, acc[mt][nt][3] * r3);
        *(u32x2*)(p.f_CvT() + ((long)((bl * 8 + (n >> 6)) * 64 + (n & 63))) * 2048 + j * 128 + i0) = o;
      }
    }
  }
  __syncthreads();
}

DEVI void p2_kpe_item(const P& p, int gg, int item) {
  const int tid = TID();
  const int tokl = item * 128 + (tid >> 1), i0 = (tid & 1) * 8;
  const bf16_t* src = p.f_Y() + (long)tokl * LDY + YKPE;
  const u32x4 a = *(const u32x4*)(src + i0), b = *(const u32x4*)(src + 16 + i0);
  const float2* tb = p.f_ropeC() + ((long)gg * TG + tokl) * 16 + i0;
  float x1[8] = {lo2f(a.x), hi2f(a.x), lo2f(a.y), hi2f(a.y), lo2f(a.z), hi2f(a.z), lo2f(a.w), hi2f(a.w)};
  float x2[8] = {lo2f(b.x), hi2f(b.x), lo2f(b.y), hi2f(b.y), lo2f(b.z), hi2f(b.z), lo2f(b.w), hi2f(b.w)};
  float y1[8], y2[8];
#pragma unroll
  for (int i = 0; i < 8; ++i) { const float2 cs = tb[i]; y1[i] = x1[i] * cs.x - x2[i] * cs.y; y2[i] = x2[i] * cs.x + x1[i] * cs.y; }
  u32x4 o1, o2;
  o1.x = pk2(y1[0], y1[1]); o1.y = pk2(y1[2], y1[3]); o1.z = pk2(y1[4], y1[5]); o1.w = pk2(y1[6], y1[7]);
  o2.x = pk2(y2[0], y2[1]); o2.y = pk2(y2[2], y2[3]); o2.z = pk2(y2[4], y2[5]); o2.w = pk2(y2[6], y2[7]);
#pragma unroll
  for (int hh = 0; hh < 8; ++hh) {
    bf16_t* d = p.f_Kc() + (long)tokl * 768 + hh * 96 + 64 + i0;
    *(u32x4*)d = o1; *(u32x4*)(d + 16) = o2;
  }
}

template <int DQK, int NMAP, int DV, int QT>
DEVI void attn_core(const bf16_t* __restrict__ Q, long ldq, const bf16_t* __restrict__ Kb, long ldk,
                    const bf16_t* __restrict__ VT, long ldv, int kt_lo, int kt_hi, int q0, int win, float scale2,
                    f32x4 (&O)[QT][NMAP][DV / 16], float (&mrun)[QT][NMAP], float (&lrun)[QT][NMAP], bf16_t* sm) {
  constexpr int KC = NMAP * DQK, NKS = DQK / 32, NDT = DV / 16;
  constexpr int KCPR = KC / 8;
  constexpr int KST = (KC > 64) ? 128 : 64;
  constexpr int KXM = (KC > 64) ? 15 : 7;
  constexpr int KCH = 64 * KCPR / 256, VCH = DV * 8 / 256;
  bf16_t* Ks = sm; bf16_t* Vs = sm + 64 * KST;
  const int tid = TID(), lane = tid & 63, wid = tid >> 6, g = lane >> 4, lr = lane & 15;
  bf16x8 qf[QT][NMAP][NKS];
#pragma unroll
  for (int qi = 0; qi < QT; ++qi) {
    const bf16_t* qrow = Q + (long)(qi * 64 + wid * 16 + lr) * ldq;
#pragma unroll
    for (int m = 0; m < NMAP; ++m)
#pragma unroll
      for (int ks = 0; ks < NKS; ++ks) qf[qi][m][ks] = ldfrag(qrow + m * DQK + ks * 32 + g * 8);
  }
#pragma unroll
  for (int qi = 0; qi < QT; ++qi)
#pragma unroll
    for (int m = 0; m < NMAP; ++m) {
      mrun[qi][m] = -1e30f; lrun[qi][m] = 0.f;
#pragma unroll
      for (int dt = 0; dt < NDT; ++dt) O[qi][m][dt] = (f32x4){0.f, 0.f, 0.f, 0.f};
    }
  u32x4 rk[KCH], rv[VCH];
#pragma unroll
  for (int i = 0; i < KCH; ++i) { const int c = tid + 256 * i; rk[i] = *(const u32x4*)(Kb + (long)(kt_lo * 64 + c / KCPR) * ldk + (c % KCPR) * 8); }
#pragma unroll
  for (int i = 0; i < VCH; ++i) { const int c = tid + 256 * i; rv[i] = *(const u32x4*)(VT + (long)(c >> 3) * ldv + kt_lo * 64 + (c & 7) * 8); }
  const int qpos0 = q0 + wid * 16 + lr;
  for (int kt = kt_lo; kt < kt_hi; ++kt) {
    __syncthreads();
#pragma unroll
    for (int i = 0; i < KCH; ++i) {
      const int c = tid + 256 * i, row = c / KCPR, ch = c % KCPR;
      const int fsw = (KC > 64) ? (row & 15) : ((row >> 1) & 7);
      *(u32x4*)&Ks[row * KST + ((ch ^ fsw) & KXM) * 8] = rk[i];
    }
#pragma unroll
    for (int i = 0; i < VCH; ++i) { const int c = tid + 256 * i; *(u32x4*)&Vs[(c >> 3) * 72 + (c & 7) * 8] = rv[i]; }
    __syncthreads();
    if (kt + 1 < kt_hi) {
#pragma unroll
      for (int i = 0; i < KCH; ++i) { const int c = tid + 256 * i; rk[i] = *(const u32x4*)(Kb + (long)((kt + 1) * 64 + c / KCPR) * ldk + (c % KCPR) * 8); }
#pragma unroll
      for (int i = 0; i < VCH; ++i) { const int c = tid + 256 * i; rv[i] = *(const u32x4*)(VT + (long)(c >> 3) * ldv + (kt + 1) * 64 + (c & 7) * 8); }
    }
    const bool need_mask = (kt * 64 + 63 > q0) || (kt * 64 < q0 + (QT * 64 - 1) - win);
    bf16x8 pb[QT][NMAP][2];
#pragma unroll
    for (int m = 0; m < NMAP; ++m) {
      f32x4 s[QT][4];
#pragma unroll
      for (int qi = 0; qi < QT; ++qi)
#pragma unroll
        for (int t4 = 0; t4 < 4; ++t4) s[qi][t4] = (f32x4){0.f, 0.f, 0.f, 0.f};
#pragma unroll
      for (int ks = 0; ks < NKS; ++ks) {
        const int ch = (m * DQK + ks * 32) / 8 + g;
        const int fsw = (KC > 64) ? lr : ((lr >> 1) & 7);
        bf16x8 kf[4];
#pragma unroll
        for (int t4 = 0; t4 < 4; ++t4) kf[t4] = ldfrag(&Ks[(t4 * 16 + lr) * KST + ((ch ^ fsw) & KXM) * 8]);
        __builtin_amdgcn_sched_barrier(0);
#pragma unroll
        for (int qi = 0; qi < QT; ++qi)
#pragma unroll
          for (int t4 = 0; t4 < 4; ++t4) s[qi][t4] = mma(kf[t4], qf[qi][m][ks], s[qi][t4]);
        __builtin_amdgcn_sched_barrier(0);
      }
#pragma unroll
      for (int qi = 0; qi < QT; ++qi) {
        const int qpos = qpos0 + qi * 64;
        float mx = -1e30f;
#pragma unroll
        for (int t4 = 0; t4 < 4; ++t4)
#pragma unroll
          for (int r = 0; r < 4; ++r) {
            float v = s[qi][t4][r];
            if (need_mask) { const int kpos = kt * 64 + t4 * 16 + g * 4 + r; if (kpos > qpos || kpos < qpos - win) v = -1e30f; }
            s[qi][t4][r] = v; mx = fmaxf(mx, v);
          }
        mx = fmaxf(mx, __shfl_xor(mx, 16)); mx = fmaxf(mx, __shfl_xor(mx, 32));
        const float mnew = fmaxf(mrun[qi][m], mx * scale2);
        const float alpha = ex2(mrun[qi][m] - mnew);
        mrun[qi][m] = mnew;
        const float msafe = (mnew < -1e29f) ? 0.f : mnew;
        float ls = 0.f;
#pragma unroll
        for (int t4 = 0; t4 < 4; ++t4)
#pragma unroll
          for (int r = 0; r < 4; ++r) { const float pv = ex2(__builtin_fmaf(s[qi][t4][r], scale2, -msafe)); s[qi][t4][r] = pv; ls += pv; }
        lrun[qi][m] = lrun[qi][m] * alpha + ls;
        if (__builtin_amdgcn_ballot_w64(alpha != 1.f) != 0ull) {
#pragma unroll
          for (int dt = 0; dt < NDT; ++dt) O[qi][m][dt] *= alpha;
        }
#pragma unroll
        for (int kk = 0; kk < 2; ++kk) {
          u32x4 u;
          u.x = pk2(s[qi][2 * kk][0], s[qi][2 * kk][1]); u.y = pk2(s[qi][2 * kk][2], s[qi][2 * kk][3]);
          u.z = pk2(s[qi][2 * kk + 1][0], s[qi][2 * kk + 1][1]); u.w = pk2(s[qi][2 * kk + 1][2], s[qi][2 * kk + 1][3]);
          pb[qi][m][kk] = __builtin_bit_cast(bf16x8, u);
        }
      }
      __builtin_amdgcn_sched_barrier(0);
    }
    {
#pragma unroll
      for (int dg = 0; dg < NDT / 4; ++dg)
#pragma unroll
        for (int kk = 0; kk < 2; ++kk) {
          bf16x8 va[4];
#pragma unroll
          for (int j4 = 0; j4 < 4; ++j4) {
            const int dt = dg * 4 + j4;
            const u32x2 v0 = *(const u32x2*)&Vs[(dt * 16 + lr) * 72 + (2 * kk) * 16 + g * 4];
            const u32x2 v1 = *(const u32x2*)&Vs[(dt * 16 + lr) * 72 + (2 * kk + 1) * 16 + g * 4];
            u32x4 u; u.x = v0.x; u.y = v0.y; u.z = v1.x; u.w = v1.y;
            va[j4] = __builtin_bit_cast(bf16x8, u);
          }
          __builtin_amdgcn_sched_barrier(0);
#pragma unroll
          for (int m = 0; m < NMAP; ++m)
#pragma unroll
            for (int qi = 0; qi < QT; ++qi)
#pragma unroll
              for (int j4 = 0; j4 < 4; ++j4) O[qi][m][dg * 4 + j4] = mma(va[j4], pb[qi][m][kk], O[qi][m][dg * 4 + j4]);
          __builtin_amdgcn_sched_barrier(0);
        }
    }
  }
#pragma unroll
  for (int qi = 0; qi < QT; ++qi)
#pragma unroll
    for (int m = 0; m < NMAP; ++m) { lrun[qi][m] += __shfl_xor(lrun[qi][m], 16); lrun[qi][m] += __shfl_xor(lrun[qi][m], 32); }
  __syncthreads();
}

DEVI void attnA_item(const P& p, int l, int a, char* smem) {
  const int tid = TID(), lane = tid & 63, wid = tid >> 6, g = lane >> 4, lr = lane & 15;
  const int qt = 31 - (a >> 5), bh = a & 31, bl = bh >> 2, hh = bh & 3;
  const bf16_t* Yb = p.f_Y() + (long)(bl * 2048) * LDY;
  f32x4 O1[1][2][8]; float mr1[1][2], ls1[1][2];
  auto& O = O1[0]; auto& mr = mr1[0]; auto& ls = ls1[0];
  attn_core<64, 2, 128, 1>(Yb + (long)(qt * 64) * LDY + YA_Q + hh * 128, LDY, Yb + YA_K + hh * 128, LDY,
                        p.f_AvT() + (long)((bl * 4 + hh) * 128) * 2048, 2048, 0, qt + 1, qt * 64, 1 << 30, 0.125f * LOG2E, O1, mr1, ls1,
                        (bf16_t*)smem);
  (void)mr;
  const float lam = p.f_lam()[l];
  const float lam_init = 0.8f - 0.6f * __expf(-0.3f * (float)l);
  const float i1 = 1.f / ls[0], i2 = lam / ls[1];
  float ss = 0.f;
#pragma unroll
  for (int dt = 0; dt < 8; ++dt)
#pragma unroll
    for (int r = 0; r < 4; ++r) { const float o = O[0][dt][r] * i1 - O[1][dt][r] * i2; O[0][dt][r] = o; ss += o * o; }
  ss += __shfl_xor(ss, 16); ss += __shfl_xor(ss, 32);
  const float rn = rsqrtf(ss * (1.f / 128.f) + EPS) * (1.f - lam_init);
  const int tokl = bl * 2048 + qt * 64 + wid * 16 + lr;
#pragma unroll
  for (int dt = 0; dt < 8; ++dt) {
    const int d = dt * 16 + g * 4;
    const float4 gn = *(const float4*)(p.subln_g + l * 128 + d);
    const u32x2 z = *(const u32x2*)(p.f_Y() + (long)tokl * LDY + YZ + hh * 128 + d);
    u32x2 o;
    o.x = pk2(O[0][dt][0] * rn * gn.x * siluf(lo2f(z.x)), O[0][dt][1] * rn * gn.y * siluf(hi2f(z.x)));
    o.y = pk2(O[0][dt][2] * rn * gn.z * siluf(lo2f(z.y)), O[0][dt][3] * rn * gn.w * siluf(hi2f(z.y)));
    *(u32x2*)(p.f_br() + (long)tokl * 2048 + hh * 128 + d) = o;
  }
}

DEVI void attnC_item(const P& p, int a, char* smem) {
  const int tid = TID(), lane = tid & 63, wid = tid >> 6, g = lane >> 4, lr = lane & 15;
  const int qt = 15 - (a >> 6), bh = a & 63, bl = bh >> 3, hh = bh & 7;
  f32x4 O[2][1][4]; float mr[2][1], ls[2][1];
  attn_core<96, 1, 64, 2>(p.f_Qc() + (long)(bl * 2048 + qt * 128) * 768 + hh * 96, 768, p.f_Kc() + (long)(bl * 2048) * 768 + hh * 96, 768,
                          p.f_CvT() + (long)((bl * 8 + hh) * 64) * 2048, 2048, 0, 2 * qt + 2, qt * 128, 1 << 30, 0.10206207261596575f * LOG2E, O, mr, ls,
                          (bf16_t*)smem);
#pragma unroll
  for (int qi = 0; qi < 2; ++qi) {
    const float il = 1.f / ls[qi][0];
    const int tokl = bl * 2048 + qt * 128 + qi * 64 + wid * 16 + lr;
#pragma unroll
    for (int dt = 0; dt < 4; ++dt) {
      const int d = dt * 16 + g * 4;
      const u32x2 z = *(const u32x2*)(p.f_Y() + (long)tokl * LDY + YZ + 1024 + hh * 64 + d);
      u32x2 o;
      o.x = pk2(O[qi][0][dt][0] * il * siluf(lo2f(z.x)), O[qi][0][dt][1] * il * siluf(hi2f(z.x)));
      o.y = pk2(O[qi][0][dt][2] * il * siluf(lo2f(z.y)), O[qi][0][dt][3] * il * siluf(hi2f(z.y)));
      *(u32x2*)(p.f_br() + (long)tokl * 2048 + 1024 + hh * 64 + d) = o;
    }
  }
}

DEVI void attnD_item(const P& p, int a, char* smem) {
  const int tid = TID(), lane = tid & 63, wid = tid >> 6, g = lane >> 4, lr = lane & 15;
  const int qt = a & 15, rest = a >> 4, hh = rest & 7, bl = (rest >> 3) & 7, gi = rest >> 6;
  const int dl = gi == 0 ? 1 : (gi == 1 ? 4 : 16), L = 2048 / dl;
  const int q0 = qt * 128, ss = (q0 / L) * L;
  const int lo = (q0 - 128 > ss) ? (q0 - 128) : ss;
  const bf16_t* Yb = p.f_Y() + (long)(bl * 2048) * LDY;
  f32x4 O[2][1][4]; float mr[2][1], ls[2][1];
  attn_core<64, 1, 64, 2>(Yb + (long)q0 * LDY + YD_Q + gi * 512 + hh * 64, LDY, Yb + YD_K + gi * 512 + hh * 64, LDY,
                          p.f_DvT() + (long)(((gi * 8 + bl) * 8 + hh) * 64) * 2048, 2048, lo >> 6, 2 * qt + 2, q0, 128, 0.125f * LOG2E, O, mr, ls,
                          (bf16_t*)smem);
#pragma unroll
  for (int qi = 0; qi < 2; ++qi) {
    const float il = 1.f / ls[qi][0];
    const int ppos = q0 + qi * 64 + wid * 16 + lr;
    const int s = (ppos % L) * dl + ppos / L;
    const long tokl = (long)gi * TG + bl * 2048 + s;
#pragma unroll
    for (int dt = 0; dt < 4; ++dt) {
      const int d = dt * 16 + g * 4;
      u32x2 o; o.x = pk2(O[qi][0][dt][0] * il, O[qi][0][dt][1] * il); o.y = pk2(O[qi][0][dt][2] * il, O[qi][0][dt][3] * il);
      *(u32x2*)(p.f_Do() + tokl * 512 + hh * 64 + d) = o;
    }
    if (g == 0) p.f_Dlse()[tokl * 8 + hh] = (mr[qi][0] + __log2f(ls[qi][0])) * LN2;
  }
}

DEVI void dcomb_item(const P& p, int item) {
  const int tid = TID();
  const int tokl = item * 128 + (tid >> 1), h0 = (tid & 1) * 4;
  for (int hq = 0; hq < 4; ++hq) {
    const int hh = h0 + hq;
    const float l0 = p.f_Dlse()[((long)0 * TG + tokl) * 8 + hh], l1 = p.f_Dlse()[((long)1 * TG + tokl) * 8 + hh], l2 = p.f_Dlse()[((long)2 * TG + tokl) * 8 + hh];
    const float mx = fmaxf(l0, fmaxf(l1, l2));
    float w0 = __expf(l0 - mx), w1 = __expf(l1 - mx), w2 = __expf(l2 - mx);
    const float inv = 1.f / (w0 + w1 + w2);
    w0 *= inv; w1 *= inv; w2 *= inv;
#pragma unroll
    for (int c = 0; c < 8; ++c) {
      const int col = hh * 64 + c * 8;
      const u32x4 a = *(const u32x4*)(p.f_Do() + ((long)0 * TG + tokl) * 512 + col);
      const u32x4 b = *(const u32x4*)(p.f_Do() + ((long)1 * TG + tokl) * 512 + col);
      const u32x4 cc = *(const u32x4*)(p.f_Do() + ((long)2 * TG + tokl) * 512 + col);
      const u32x4 z = *(const u32x4*)(p.f_Y() + (long)tokl * LDY + YZ + 1536 + col);
      u32x4 o;
      o.x = pk2((w0 * lo2f(a.x) + w1 * lo2f(b.x) + w2 * lo2f(cc.x)) * siluf(lo2f(z.x)), (w0 * hi2f(a.x) + w1 * hi2f(b.x) + w2 * hi2f(cc.x)) * siluf(hi2f(z.x)));
      o.y = pk2((w0 * lo2f(a.y) + w1 * lo2f(b.y) + w2 * lo2f(cc.y)) * siluf(lo2f(z.y)), (w0 * hi2f(a.y) + w1 * hi2f(b.y) + w2 * hi2f(cc.y)) * siluf(hi2f(z.y)));
      o.z = pk2((w0 * lo2f(a.z) + w1 * lo2f(b.z) + w2 * lo2f(cc.z)) * siluf(lo2f(z.z)), (w0 * hi2f(a.z) + w1 * hi2f(b.z) + w2 * hi2f(cc.z)) * siluf(hi2f(z.z)));
      o.w = pk2((w0 * lo2f(a.w) + w1 * lo2f(b.w) + w2 * lo2f(cc.w)) * siluf(lo2f(z.w)), (w0 * hi2f(a.w) + w1 * hi2f(b.w) + w2 * hi2f(cc.w)) * siluf(hi2f(z.w)));
      *(u32x4*)(p.f_br() + (long)tokl * 2048 + 1536 + col) = o;
    }
  }
}

DEVI void b1_item(const P& p, int l, int item, char* smem) {
  const int tid = TID(), lane = tid & 63, wid = tid >> 6, g = lane >> 4, lr = lane & 15;
  const int n = item & 31, hh = (item >> 5) & 3, bl = item >> 7;
  const int tok0 = bl * 2048 + n * 64;
  bf16_t* qs = (bf16_t*)smem;
  bf16_t* ks = qs + 64 * 136;
  bf16_t* vs = ks + 64 * 136;
  float* Lm = (float*)(smem + 52224);
  float* gcs = (float*)(smem + 52224 + 17408);
  float* betas = gcs + 64;
#pragma unroll 1
  for (int it = 0; it < 12; ++it) {
    const int part = it >> 2;
    const int wi = (it & 3) * 256 + tid;
    const int t = wi >> 4, c0 = (wi & 15) * 8;
    const int ccol = part * 512 + hh * 128 + c0;
    float acc[8];
#pragma unroll
    for (int e = 0; e < 8; ++e) acc[e] = 0.f;
#pragma unroll
    for (int jj = 0; jj < 4; ++jj) {
      const int sidx = n * 64 + t - 3 + jj;
      if (sidx >= 0) {
        const u32x4 xv = *(const u32x4*)(p.f_Y() + (long)(bl * 2048 + sidx) * LDY + YB_Q + ccol);
        const float4 wa = *(const float4*)(p.conv_b + ((long)l * 4 + jj) * 1536 + ccol);
        const float4 wb = *(const float4*)(p.conv_b + ((long)l * 4 + jj) * 1536 + ccol + 4);
        acc[0] += lo2f(xv.x) * wa.x; acc[1] += hi2f(xv.x) * wa.y; acc[2] += lo2f(xv.y) * wa.z; acc[3] += hi2f(xv.y) * wa.w;
        acc[4] += lo2f(xv.z) * wb.x; acc[5] += hi2f(xv.z) * wb.y; acc[6] += lo2f(xv.w) * wb.z; acc[7] += hi2f(xv.w) * wb.w;
      }
    }
    float ssq = 0.f;
#pragma unroll
    for (int e = 0; e < 8; ++e) { acc[e] = siluf(acc[e]); ssq += acc[e] * acc[e]; }
    float sc = 1.f;
    if (part < 2) {
      ssq += __shfl_xor(ssq, 1); ssq += __shfl_xor(ssq, 2); ssq += __shfl_xor(ssq, 4); ssq += __shfl_xor(ssq, 8);
      sc = rsqrtf(ssq + EPS);
      if (part == 0) sc *= 0.08838834764831845f;
    }
    u32x4 o;
    o.x = pk2(acc[0] * sc, acc[1] * sc); o.y = pk2(acc[2] * sc, acc[3] * sc); o.z = pk2(acc[4] * sc, acc[5] * sc); o.w = pk2(acc[6] * sc, acc[7] * sc);
    bf16_t* dst = (part == 0 ? qs : (part == 1 ? ks : vs)) + t * 136 + c0;
    *(u32x4*)dst = o;
  }
  if (wid == 0) {
    const bf16_t* yr = p.f_Y() + (long)(tok0 + lane) * LDY;
    const float bv = sigmf(bf2f(yr[YBETA + hh]));
    const float xd = bf2f(yr[YDECAY + hh]) + p.dt_bias[l * 4 + hh];
    const float sp = (xd > 20.f) ? xd : log1pf(__expf(xd));
    float gc = -__expf(p.a_log[l * 4 + hh]) * sp;
#pragma unroll
    for (int o = 1; o < 64; o <<= 1) { const float v = __shfl_up(gc, o); if (lane >= o) gc += v; }
    gcs[lane] = gc; betas[lane] = bv;
  }
  __syncthreads();
  {
    bf16_t* qkdst = p.f_QKm() + (long)item * 4096;
#pragma unroll
    for (int nt = 0; nt < 4; ++nt) {
      f32x4 akk = (f32x4){0.f, 0.f, 0.f, 0.f}, aqk = (f32x4){0.f, 0.f, 0.f, 0.f};
#pragma unroll
      for (int k4 = 0; k4 < 4; ++k4) {
        const bf16x8 bfr = ldfrag(&ks[(nt * 16 + lr) * 136 + k4 * 32 + g * 8]);
        akk = mma(ldfrag(&ks[(wid * 16 + lr) * 136 + k4 * 32 + g * 8]), bfr, akk);
        aqk = mma(ldfrag(&qs[(wid * 16 + lr) * 136 + k4 * 32 + g * 8]), bfr, aqk);
      }
      const int jc = nt * 16 + lr;
      const float gj = gcs[jc];
      float lt4[4];
#pragma unroll
      for (int r = 0; r < 4; ++r) {
        const int i = wid * 16 + g * 4 + r;
        const float dec = (i >= jc) ? __expf(gcs[i] - gj) : 0.f;
        lt4[r] = (i > jc) ? betas[i] * akk[r] * dec : 0.f;
        qkdst[i * 64 + jc] = f2bf(aqk[r] * dec);
      }
      *(float4*)&Lm[jc * 68 + wid * 16 + g * 4] = make_float4(lt4[0], lt4[1], lt4[2], lt4[3]);
    }
  }
  {
    const float glast = gcs[63];
#pragma unroll
    for (int it = 0; it < 4; ++it) {
      const int idx = tid + 256 * it;
      const int i = idx >> 4, c0 = (idx & 15) * 8;
      const float e = __expf(gcs[i]);
      const u32x4 u = *(const u32x4*)&qs[i * 136 + c0];
      u32x4 o;
      o.x = pk2(lo2f(u.x) * e, hi2f(u.x) * e); o.y = pk2(lo2f(u.y) * e, hi2f(u.y) * e); o.z = pk2(lo2f(u.z) * e, hi2f(u.z) * e); o.w = pk2(lo2f(u.w) * e, hi2f(u.w) * e);
      *(u32x4*)(p.f_QG() + (long)item * 8192 + i * 128 + c0) = o;
    }
    const int dk = tid >> 1, ih = (tid & 1) * 32;
    bf16_t* d = p.f_KGT() + (long)item * 8192 + dk * 64 + ih;
#pragma unroll
    for (int q = 0; q < 4; ++q) {
      float v[8];
#pragma unroll
      for (int e = 0; e < 8; ++e) { const int i = ih + q * 8 + e; v[e] = bf2f(ks[i * 136 + dk]) * __expf(glast - gcs[i]); }
      u32x4 o; o.x = pk2(v[0], v[1]); o.y = pk2(v[2], v[3]); o.z = pk2(v[4], v[5]); o.w = pk2(v[6], v[7]);
      *(u32x4*)(d + q * 8) = o;
    }
    if (tid == 0) p.f_dlast()[item] = __expf(glast);
  }
  __syncthreads();
  {
    const int which = wid >> 1, c = (wid & 1) * 64 + lane;
    const bf16_t* rsrc = which == 0 ? vs : ks;
    bf16_t* xdst = which == 0 ? vs : qs;
#pragma unroll 1
    for (int ib = 0; ib < 4; ++ib) {
      float a[16];
#pragma unroll
      for (int r = 0; r < 16; ++r) {
        const int i = ib * 16 + r;
        float rhs = bf2f(rsrc[i * 136 + c]) * betas[i];
        if (which) rhs *= __expf(gcs[i]);
        a[r] = rhs;
      }
#pragma unroll 1
      for (int j = 0; j < ib * 16; ++j) {
        const float xj = bf2f(xdst[j * 136 + c]);
        const float4 l0 = *(const float4*)&Lm[j * 68 + ib * 16 + 0], l1 = *(const float4*)&Lm[j * 68 + ib * 16 + 4];
        const float4 l2 = *(const float4*)&Lm[j * 68 + ib * 16 + 8], l3 = *(const float4*)&Lm[j * 68 + ib * 16 + 12];
        a[0] -= l0.x * xj; a[1] -= l0.y * xj; a[2] -= l0.z * xj; a[3] -= l0.w * xj;
        a[4] -= l1.x * xj; a[5] -= l1.y * xj; a[6] -= l1.z * xj; a[7] -= l1.w * xj;
        a[8] -= l2.x * xj; a[9] -= l2.y * xj; a[10] -= l2.z * xj; a[11] -= l2.w * xj;
        a[12] -= l3.x * xj; a[13] -= l3.y * xj; a[14] -= l3.z * xj; a[15] -= l3.w * xj;
      }
#pragma unroll
      for (int jj = 0; jj < 15; ++jj) {
        const float xj = a[jj];
        const float* lrow = &Lm[(ib * 16 + jj) * 68 + ib * 16];
#pragma unroll
        for (int r4 = 0; r4 < 4; ++r4) {
          if (r4 * 4 + 3 > jj) {
            const float4 lv = *(const float4*)(lrow + r4 * 4);
            if (r4 * 4 + 0 > jj) a[r4 * 4 + 0] -= lv.x * xj;
            if (r4 * 4 + 1 > jj) a[r4 * 4 + 1] -= lv.y * xj;
            if (r4 * 4 + 2 > jj) a[r4 * 4 + 2] -= lv.z * xj;
            if (r4 * 4 + 3 > jj) a[r4 * 4 + 3] -= lv.w * xj;
          }
        }
      }
#pragma unroll
      for (int r = 0; r < 16; ++r) xdst[(ib * 16 + r) * 136 + c] = f2bf(a[r]);
      if (which == 0) {
        bf16_t* d = p.f_UT() + (long)item * 8192 + c * 64 + ib * 16;
        u32x4 o0, o1;
        o0.x = pk2(a[0], a[1]); o0.y = pk2(a[2], a[3]); o0.z = pk2(a[4], a[5]); o0.w = pk2(a[6], a[7]);
        o1.x = pk2(a[8], a[9]); o1.y = pk2(a[10], a[11]); o1.z = pk2(a[12], a[13]); o1.w = pk2(a[14], a[15]);
        *(u32x4*)d = o0; *(u32x4*)(d + 8) = o1;
      } else {
        bf16_t* d = p.f_Wm() + (long)item * 8192 + (ib * 16) * 128 + c;
#pragma unroll
        for (int r = 0; r < 16; ++r) d[r * 128] = f2bf(a[r]);
      }
    }
  }
  __syncthreads();
}

DEVI void b2_item(const P& p, int l, int item, char* smem) {
  const int tid = TID(), lane = tid & 63, wid = tid >> 6, g = lane >> 4, lr = lane & 15;
  const int bl = item >> 2, hh = item & 3;
  bf16_t* ST = (bf16_t*)smem;
  bf16_t* VNT = ST + 128 * 144;
  for (int i = tid; i < 128 * 144 / 2; i += 256) ((unsigned*)ST)[i] = 0u;
  f32x4 Sacc[2][8];
#pragma unroll
  for (int a = 0; a < 2; ++a)
#pragma unroll
    for (int b = 0; b < 8; ++b) Sacc[a][b] = (f32x4){0.f, 0.f, 0.f, 0.f};
  bf16x8 fw[4], fq[4], fqk[2], fk[2][2];
  u32x2 fu[8], fz[8];
  float dlv;
  const long it0 = (long)item * 32;
  const long tok0 = (long)bl * 2048 + wid * 16 + lr;
  const bf16_t* zbase = p.f_Y() + YZ + 512 + hh * 128 + (long)bl * 2048 * LDY;
  const unsigned vW = (unsigned)((wid * 16 + lr) * 128 + g * 8) * 2u;
  const unsigned vU = (unsigned)(lr * 64 + wid * 16 + g * 4) * 2u;
  const unsigned vQ = (unsigned)((wid * 16 + lr) * 64 + g * 8) * 2u;
  const unsigned vK = (unsigned)((2 * wid * 16 + lr) * 64 + g * 8) * 2u;
  const unsigned vZ = (unsigned)((wid * 16 + lr) * LDY + g * 4) * 2u;
#define LDF(base, voff) (*(const bf16x8*)((const char*)(base) + (voff)))
#define LD2(base, voff) (*(const u32x2*)((const char*)(base) + (voff)))
  {
    const bf16_t* Wp = p.f_Wm() + it0 * 8192; const bf16_t* UTp = p.f_UT() + it0 * 8192; const bf16_t* QGp0 = p.f_QG() + it0 * 8192;
#pragma unroll
    for (int k4 = 0; k4 < 4; ++k4) { fw[k4] = LDF(Wp + k4 * 32, vW); fq[k4] = LDF(QGp0 + k4 * 32, vW); }
    {
      const bf16_t* QKp = p.f_QKm() + it0 * 4096; const bf16_t* KGp = p.f_KGT() + it0 * 8192;
#pragma unroll
      for (int k2 = 0; k2 < 2; ++k2) { fqk[k2] = LDF(QKp + k2 * 32, vQ); fk[0][k2] = LDF(KGp + k2 * 32, vK); fk[1][k2] = LDF(KGp + 16 * 64 + k2 * 32, vK); }
#pragma unroll
      for (int nt = 0; nt < 8; ++nt) fz[nt] = LD2(zbase + nt * 16, vZ);
      dlv = p.f_dlast()[it0];
    }
#pragma unroll
    for (int nt = 0; nt < 8; ++nt) fu[nt] = LD2(UTp + nt * 16 * 64, vU);
  }
#pragma unroll 1
  for (int n = 0; n < 32; ++n) {
    const int nn = (n + 1 < 32) ? n + 1 : 31;
    const long itn = it0 + nn;
    const long tokl = tok0 + n * 64;
    {
      const long it = it0 + n;
    }
    __syncthreads();
    f32x4 ao[8];
#pragma unroll
    for (int hf = 0; hf < 2; ++hf) {
      f32x4 av[4];
#pragma unroll
      for (int q4 = 0; q4 < 4; ++q4) av[q4] = (f32x4){0.f, 0.f, 0.f, 0.f};
#pragma unroll
      for (int k4 = 0; k4 < 4; ++k4) {
        bf16x8 fa[4];
#pragma unroll
        for (int q4 = 0; q4 < 4; ++q4) fa[q4] = ldfrag(&ST[((hf * 4 + q4) * 16 + lr) * 144 + k4 * 32 + g * 8]);
        __builtin_amdgcn_sched_barrier(0);
#pragma unroll
        for (int q4 = 0; q4 < 4; ++q4) av[q4] = mma(fw[k4], fa[q4], av[q4]);
        __builtin_amdgcn_sched_barrier(0);
      }
#pragma unroll
      for (int q4 = 0; q4 < 4; ++q4) {
        const int nt = hf * 4 + q4;
        u32x2 o; o.x = pk2(lo2f(fu[nt].x) - av[q4][0], hi2f(fu[nt].x) - av[q4][1]); o.y = pk2(lo2f(fu[nt].y) - av[q4][2], hi2f(fu[nt].y) - av[q4][3]);
        *(u32x2*)&VNT[(nt * 16 + lr) * 80 + wid * 16 + g * 4] = o;
      }
      __builtin_amdgcn_sched_barrier(0);
    }
    {
      const bf16_t* Wp = p.f_Wm() + itn * 8192; const bf16_t* UTp = p.f_UT() + itn * 8192;
#pragma unroll
      for (int k4 = 0; k4 < 4; ++k4) fw[k4] = LDF(Wp + k4 * 32, vW);
#pragma unroll
      for (int nt = 0; nt < 8; ++nt) fu[nt] = LD2(UTp + nt * 16 * 64, vU);
    }
#pragma unroll
    for (int nt = 0; nt < 8; ++nt) ao[nt] = (f32x4){0.f, 0.f, 0.f, 0.f};
#pragma unroll
    for (int gi = 0; gi < 8; ++gi) {
      bf16x8 fa[4];
#pragma unroll
      for (int q4 = 0; q4 < 4; ++q4) fa[q4] = ldfrag(&ST[(((gi & 1) * 4 + q4) * 16 + lr) * 144 + (gi >> 1) * 32 + g * 8]);
      __builtin_amdgcn_sched_barrier(0);
#pragma unroll
      for (int q4 = 0; q4 < 4; ++q4) ao[(gi & 1) * 4 + q4] = mma(fa[q4], fq[gi >> 1], ao[(gi & 1) * 4 + q4]);
      __builtin_amdgcn_sched_barrier(0);
    }
    __builtin_amdgcn_sched_barrier(0);
    {
      const bf16_t* QGp = p.f_QG() + itn * 8192;
#pragma unroll
      for (int k4 = 0; k4 < 4; ++k4) fq[k4] = LDF(QGp + k4 * 32, vW);
    }
    __syncthreads();
#pragma unroll
    for (int gi = 0; gi < 4; ++gi) {
      bf16x8 fa[4];
#pragma unroll
      for (int q4 = 0; q4 < 4; ++q4) fa[q4] = ldfrag(&VNT[(((gi & 1) * 4 + q4) * 16 + lr) * 80 + (gi >> 1) * 32 + g * 8]);
      __builtin_amdgcn_sched_barrier(0);
#pragma unroll
      for (int q4 = 0; q4 < 4; ++q4) ao[(gi & 1) * 4 + q4] = mma(fa[q4], fqk[gi >> 1], ao[(gi & 1) * 4 + q4]);
      __builtin_amdgcn_sched_barrier(0);
    }
    __builtin_amdgcn_sched_barrier(0);
    {
      const bf16_t* QKp = p.f_QKm() + itn * 4096;
#pragma unroll
      for (int k2 = 0; k2 < 2; ++k2) fqk[k2] = LDF(QKp + k2 * 32, vQ);
    }
    {
      float ss = 0.f;
#pragma unroll
      for (int nt = 0; nt < 8; ++nt)
#pragma unroll
        for (int r = 0; r < 4; ++r) ss += ao[nt][r] * ao[nt][r];
      ss += __shfl_xor(ss, 16); ss += __shfl_xor(ss, 32);
      const float rn = rsqrtf(ss * (1.f / 128.f) + EPS);
#pragma unroll
      for (int nt = 0; nt < 8; ++nt) {
        const int dv = nt * 16 + g * 4;
        const float4 gn = *(const float4*)(p.out_norm_b + l * 128 + dv);
        u32x2 o;
        o.x = pk2(ao[nt][0] * rn * gn.x * siluf(lo2f(fz[nt].x)), ao[nt][1] * rn * gn.y * siluf(hi2f(fz[nt].x)));
        o.y = pk2(ao[nt][2] * rn * gn.z * siluf(lo2f(fz[nt].y)), ao[nt][3] * rn * gn.w * siluf(hi2f(fz[nt].y)));
        *(u32x2*)(p.f_br() + tokl * 2048 + 512 + hh * 128 + dv) = o;
      }
    }
    __builtin_amdgcn_sched_barrier(0);
    {
#pragma unroll
      for (int nt = 0; nt < 8; ++nt) fz[nt] = LD2(zbase + (long)(nn * 64) * LDY + nt * 16, vZ);
    }
#pragma unroll
    for (int a = 0; a < 2; ++a)
#pragma unroll
      for (int nt = 0; nt < 8; ++nt) Sacc[a][nt] *= dlv;
#pragma unroll
    for (int gi = 0; gi < 4; ++gi) {
      bf16x8 fa[4];
#pragma unroll
      for (int q4 = 0; q4 < 4; ++q4) fa[q4] = ldfrag(&VNT[(((gi & 1) * 4 + q4) * 16 + lr) * 80 + (gi >> 1) * 32 + g * 8]);
      __builtin_amdgcn_sched_barrier(0);
#pragma unroll
      for (int q4 = 0; q4 < 4; ++q4) {
        const int nt = (gi & 1) * 4 + q4;
        Sacc[0][nt] = mma(fk[0][gi >> 1], fa[q4], Sacc[0][nt]); Sacc[1][nt] = mma(fk[1][gi >> 1], fa[q4], Sacc[1][nt]);
      }
      __builtin_amdgcn_sched_barrier(0);
    }
    __builtin_amdgcn_sched_barrier(0);
    {
      const bf16_t* KGp = p.f_KGT() + itn * 8192;
#pragma unroll
      for (int k2 = 0; k2 < 2; ++k2) { fk[0][k2] = LDF(KGp + k2 * 32, vK); fk[1][k2] = LDF(KGp + 16 * 64 + k2 * 32, vK); }
      dlv = p.f_dlast()[itn];
    }
#pragma unroll
    for (int a = 0; a < 2; ++a)
#pragma unroll
      for (int nt = 0; nt < 8; ++nt) {
        u32x2 o; o.x = pk2(Sacc[a][nt][0], Sacc[a][nt][1]); o.y = pk2(Sacc[a][nt][2], Sacc[a][nt][3]);
        *(u32x2*)&ST[(nt * 16 + lr) * 144 + (2 * wid + a) * 16 + g * 4] = o;
      }
  }
  __syncthreads();
}

DEVI void p4a_tile(const P& p, int l, int mtile, int ntile, char* smem) {
  const int tid = TID(), lane = tid & 63, wid = tid >> 6, g = lane >> 4, lr = lane & 15;
  const int wm = wid >> 1, wn = wid & 1;
  f32x4 tot[4][4];
  zero_acc(tot);
#pragma unroll 1
  for (int nb = 0; nb < 4; ++nb) {
    f32x4 acc[4][4];
    zero_acc(acc);
    gemm_core<true, 4>(p.f_br() + (long)(mtile * 128) * 2048 + nb * 512, 2048, p.f_wBrT() + ((long)((l * 4 + nb) * 1024) + ntile * 128) * 512, 512, 512, acc,
                       (bf16_t*)smem);
#pragma unroll
    for (int mt = 0; mt < 4; ++mt) {
      const long tokl = mtile * 128 + wm * 64 + mt * 16 + lr;
#pragma unroll
      for (int nt = 0; nt < 4; ++nt) {
        const int col = ntile * 128 + wn * 64 + nt * 16 + g * 4;
        const u32x2 gt = *(const u32x2*)(p.f_Y() + tokl * LDY + YMG + nb * 1024 + col);
        tot[mt][nt][0] += acc[mt][nt][0] * lo2f(gt.x); tot[mt][nt][1] += acc[mt][nt][1] * hi2f(gt.x);
        tot[mt][nt][2] += acc[mt][nt][2] * lo2f(gt.y); tot[mt][nt][3] += acc[mt][nt][3] * hi2f(gt.y);
      }
    }
  }
#pragma unroll
  for (int mt = 0; mt < 4; ++mt) {
    const long tokl = mtile * 128 + wm * 64 + mt * 16 + lr;
#pragma unroll
    for (int nt = 0; nt < 4; ++nt) {
      const int col = ntile * 128 + wn * 64 + nt * 16 + g * 4;
      u32x2 o; o.x = pk2(tot[mt][nt][0], tot[mt][nt][1]); o.y = pk2(tot[mt][nt][2], tot[mt][nt][3]);
      *(u32x2*)(p.f_merged() + tokl * 1024 + col) = o;
    }
  }
}

DEVI void p4b_tile(const P& p, int gg, int l, int mtile, int ntile, char* smem) {
  const int tid = TID(), lane = tid & 63, wid = tid >> 6, g = lane >> 4, lr = lane & 15;
  const int wm = wid >> 1, wn = wid & 1;
  f32x4 acc[4][4];
  zero_acc(acc);
  gemm_core<true>(p.f_merged() + (long)(mtile * 128) * 1024, 1024, p.f_wOutT() + ((long)l * 1024 + ntile * 128) * 1024, 1024, 1024, acc, (bf16_t*)smem);
  const float* xin = (l == 0) ? p.x : p.out;
  const int bglob = gg * NB + (mtile >> 4);
  const float* gate = p.f_mod() + (long)(l * 32 + bglob) * 3072 + 2048;
  const float alpha = 1.4142135623730951f;
#pragma unroll
  for (int mt = 0; mt < 4; ++mt) {
    const long tok = (long)gg * TG + mtile * 128 + wm * 64 + mt * 16 + lr;
#pragma unroll
    for (int nt = 0; nt < 4; ++nt) {
      const int col = ntile * 128 + wn * 64 + nt * 16 + g * 4;
      const float4 xv = *(const float4*)(xin + tok * 1024 + col);
      const float4 gv = *(const float4*)(gate + col);
      float4 o;
      o.x = alpha * xv.x + gv.x * acc[mt][nt][0]; o.y = alpha * xv.y + gv.y * acc[mt][nt][1];
      o.z = alpha * xv.z + gv.z * acc[mt][nt][2]; o.w = alpha * xv.w + gv.w * acc[mt][nt][3];
      *(float4*)(p.out + tok * 1024 + col) = o;
    }
  }
}

DEVI void p4c_row(const P& p, int gg, int l, long tok, int lane) {
  float* r = p.out + tok * 1024;
  float4 v[4];
#pragma unroll
  for (int i = 0; i < 4; ++i) v[i] = *(const float4*)(r + i * 256 + lane * 4);
  float mu, rstd;
  ln_stats(v, mu, rstd);
#pragma unroll
  for (int i = 0; i < 4; ++i) {
    const int col = i * 256 + lane * 4;
    const float4 gn = *(const float4*)(p.ln_g + l * 1024 + col), bb = *(const float4*)(p.ln_b + l * 1024 + col);
    v[i].x = (v[i].x - mu) * rstd * gn.x + bb.x; v[i].y = (v[i].y - mu) * rstd * gn.y + bb.y;
    v[i].z = (v[i].z - mu) * rstd * gn.z + bb.z; v[i].w = (v[i].w - mu) * rstd * gn.w + bb.w;
    *(float4*)(r + col) = v[i];
  }
  if (l == 0) {
    ln_stats(v, mu, rstd);
    const int b = (int)(tok >> 11);
    store_h(v, mu, rstd, p.f_mod() + (long)(1 * 32 + b) * 3072, p.f_h() + tok * LDH, lane);
  }
}


#define XB_TMO      128
#define XB_XCNT(j)  (256  + 64 * (j))
#define XB_XSUB(j)  (1280 + 64 * (j))
#define XB_XGEN(j)  (2304 + 64 * (j))
#define XB_TOP      3328
#define XB_TOPGEN   3392
#define XCD_BAR_WORDS 3456
#define XB_SPIN_CAP (1u << 22)
#define LAS __attribute__((address_space(3)))
DEVI unsigned xb_ld(unsigned* p) { return __hip_atomic_load(p, __ATOMIC_RELAXED, __HIP_MEMORY_SCOPE_AGENT); }
DEVI unsigned xb_add(unsigned* p, unsigned v) { return __hip_atomic_fetch_add(p, v, __ATOMIC_RELAXED, __HIP_MEMORY_SCOPE_AGENT); }
DEVI unsigned xb_xcc_id() { return (unsigned)__builtin_amdgcn_s_getreg((3 << 11) | 20) & 0xFu; }
#define XB_SPIN(cond, bar) do { unsigned _sp = 0; while (cond) { __builtin_amdgcn_s_sleep(1); \
    if ((++_sp & 255u) == 0u) { if (xb_ld(&(bar)[XB_TMO])) break; if (_sp > XB_SPIN_CAP) { atomicAdd(&(bar)[XB_TMO], 1u); break; } } } } while (0)
struct XcdBarrier { unsigned* bar; unsigned x; volatile LAS unsigned* st; };
DEVI XcdBarrier xcd_barrier_post(unsigned* bar, volatile LAS unsigned* st) {
  XcdBarrier b; b.bar = bar; b.x = xb_xcc_id(); b.st = st;
  if (threadIdx.x == 0) (void)xb_add(&bar[XB_XCNT(b.x)], 1u);
  return b;
}
DEVI void xcd_barrier_complete(unsigned* bar, unsigned x, unsigned& nloc, unsigned& nx) {
  const unsigned G = gridDim.x * gridDim.y * gridDim.z;
  unsigned sum, cnt, mine, sp = 0u;
  for (;;) {
    sum = 0u; cnt = 0u; mine = 0u;
#pragma unroll
    for (unsigned j = 0; j < 16; ++j) { const unsigned c = xb_ld(&bar[XB_XCNT(j)]); sum += c; cnt += (c > 0u) ? 1u : 0u; mine = (j == x) ? c : mine; }
    if (sum == G) break;
    __builtin_amdgcn_s_sleep(1);
    if ((++sp & 255u) == 0u) { if (xb_ld(&bar[XB_TMO])) break; if (sp > XB_SPIN_CAP) { atomicAdd(&bar[XB_TMO], 1u); break; } }
  }
  nloc = mine > 0u ? mine : 1u; nx = cnt > 0u ? cnt : 1u;
}
DEVI void xcd_barrier(const XcdBarrier& b) {
  asm volatile("s_waitcnt vmcnt(0)" ::: "memory");
  __syncthreads();
  if (threadIdx.x == 0) {
    unsigned* bar = b.bar;
    __builtin_amdgcn_s_waitcnt(0);
    unsigned nloc = b.st[0], nx = b.st[1];
    if (nloc == 0u) { xcd_barrier_complete(bar, b.x, nloc, nx); b.st[0] = nloc; b.st[1] = nx; }
    const unsigned old = xb_add(&bar[XB_XSUB(b.x)], 1u);
    const unsigned gen = old / nloc;
    if (old + 1u == (gen + 1u) * nloc) {
      __builtin_amdgcn_fence(__ATOMIC_RELEASE, "agent");
      asm volatile("s_waitcnt vmcnt(0)" ::: "memory");
      const unsigned og = xb_add(&bar[XB_TOP], 1u);
      const unsigned tg = og / nx;
      if (og + 1u == (tg + 1u) * nx) xb_add(&bar[XB_TOPGEN], 1u);
      else XB_SPIN(xb_ld(&bar[XB_TOPGEN]) == tg, bar);
      __builtin_amdgcn_fence(__ATOMIC_ACQUIRE, "agent");
      xb_add(&bar[XB_XGEN(b.x)], 1u);
      asm volatile("s_waitcnt vmcnt(0)" ::: "memory");
    } else {
      XB_SPIN(xb_ld(&bar[XB_XGEN(b.x)]) == gen, bar);
      __builtin_amdgcn_fence(__ATOMIC_ACQUIRE, "agent");
      asm volatile("s_waitcnt vmcnt(0)" ::: "memory");
    }
  }
  __syncthreads();
}

__shared__ __attribute__((aligned(16))) char g_smem[SMEM_BYTES];
__shared__ int s_item;

DEVI int next_item(int* ctr) {
  __syncthreads();
  if (threadIdx.x == 0) s_item = atomicAdd(ctr, 1);
  __syncthreads();
  return s_item;
}

struct P1Queue { int* c8; int x0; int d; };
DEVI bool p1_pop(P1Queue& qu, int& mt, int& nt) {
  while (qu.d < 8) {
    const int x = (qu.x0 + qu.d) & 7;
    const int qq = next_item(qu.c8 + x);
    if (qq < 1792) {
      const int st = qq >> 6, within = qq & 63;
      mt = 16 * x + (st & 3) * 4 + (within & 3);
      nt = (st >> 2) * 16 + (within >> 2);
      return true;
    }
    ++qu.d;
  }
  return false;
}

DEVI void p1_phase(const P& p, int gg, int l, int qidx, char* smem) {
  P1Queue qu; qu.c8 = p.f_ctr2() + qidx * 8; qu.x0 = (int)(xb_xcc_id() & 7u); qu.d = 0;
  int mt, nt;
  if (!p1_pop(qu, mt, nt)) return;
  P1Tile cur; p1_desc(p, gg, l, mt, nt, cur);
  const int tid = TID(), lrow = tid >> 3, lkc = (tid & 7) * 8;
  u32x4 ra0[4], rb0[4], ra1[4], rb1[4];
  {
    const unsigned voa = (unsigned)(lrow * (int)cur.rs + lkc) * 2u, vob = (unsigned)(lrow * LDW + lkc) * 2u;
#pragma unroll
    for (int i = 0; i < 4; ++i) {
      ra0[i] = *(const u32x4*)((const char*)(cur.A + (long)(32 * i) * cur.rs) + voa); rb0[i] = *(const u32x4*)((const char*)(cur.B + (long)(32 * i) * LDW) + vob);
    }
#pragma unroll
    for (int i = 0; i < 4; ++i) {
      ra1[i] = *(const u32x4*)((const char*)(cur.A + (long)(32 * i) * cur.rs + 64) + voa); rb1[i] = *(const u32x4*)((const char*)(cur.B + (long)(32 * i) * LDW + 64) + vob);
    }
  }
  for (;;) {
    P1Tile nxt = cur;
    const bool has_next = p1_pop(qu, mt, nt);
    if (has_next) p1_desc(p, gg, l, mt, nt, nxt);
    f32x4 acc[4][4];
    zero_acc(acc);
    if (cur.vt) gemm_stream<false>(cur.A, cur.rs, cur.B, nxt.A, nxt.rs, nxt.B, ra0, rb0, ra1, rb1, acc, (bf16_t*)smem);
    else gemm_stream<true>(cur.A, cur.rs, cur.B, nxt.A, nxt.rs, nxt.B, ra0, rb0, ra1, rb1, acc, (bf16_t*)smem);
    p1_epilogue(p, cur, acc, smem);
    if (!has_next) break;
    cur = nxt;
  }
}

template <int ph>
DEVI void run_pre(const P& p) {
  char* smem = g_smem;
  const int tid = TID(), lane = tid & 63, wid = tid >> 6;
  const int G = gridDim.x, bid = blockIdx.x;
  if (ph == 0) {
    constexpr int N0 = 96, N1 = N0 + 1, N2 = N1 + 256, N3 = N2 + 7168, N4 = N3 + 96, N5 = N4 + 64, N6 = N5 + 1024, N7 = N6 + 512;
    for (int it = bid; it < N7; it += G) {
      if (it < N0) mod_item(p, it, smem);
      else if (it < N1) {
        if (tid < 64) {
          for (int l = 0; l < 2; ++l) {
            const float s1 = wave_sum(p.lq1[l * 64 + lane] * p.lk1[l * 64 + lane]);
            const float s2 = wave_sum(p.lq2[l * 64 + lane] * p.lk2[l * 64 + lane]);
            const float lam_init = 0.8f - 0.6f * expf(-0.3f * (float)l);
            if (lane == 0) p.f_lam()[l] = expf(s1) - expf(s2) + lam_init;
          }
          for (int i = lane; i < 256; i += 64) { p.f_ctr()[i] = 0; p.f_ctr2()[i] = 0; }
        }
      } else if (it < N2) rope_item(p, it - N1);
      else if (it < N3) {
        const int q = it - N2, l = q / 3584, r = q % 3584, nt = r >> 4, kt = r & 15;
        tconv_tile<0>(p.w_in + (long)l * 1024 * 14248, 14248, p.f_wInT() + (long)l * LDY * LDW, LDW, nt * 64, kt * 64, nullptr, (float*)smem);
      } else if (it < N4) {
        const int q = it - N3, l = q / 48, r = q % 48, nt = r >> 2, kt = r & 3;
        tconv_tile<1>(p.w_uq + (long)l * 256 * 768, 768, p.f_wUqT() + (long)l * 768 * 256, 256, nt * 64, kt * 64, p.q_norm_c + l * 256, (float*)smem);
      } else if (it < N5) {
        const int q = it - N4, l = q / 32, r = q % 32, nt = r >> 1, kt = r & 1;
        tconv_tile<2>(p.w_ukv + (long)l * 128 * 1024, 1024, p.f_wUkvT() + (long)l * 1024 * 128, 128, nt * 64, kt * 64, p.kv_norm_c + l * 128, (float*)smem);
      } else if (it < N6) {
        const int q = it - N5, ln = q >> 7, r = q & 127, nt = r >> 3, kt = r & 7;
        tconv_tile<3>(p.w_br + (long)ln * 512 * 1024, 1024, p.f_wBrT() + (long)ln * 1024 * 512, 512, nt * 64, kt * 64, nullptr, (float*)smem);
      } else {
        const int q = it - N6, l = q >> 8, r = q & 255, nt = r >> 4, kt = r & 15;
        tconv_tile<3>(p.w_out + (long)l * 1024 * 1024, 1024, p.f_wOutT() + (long)l * 1024 * 1024, 1024, nt * 64, kt * 64, nullptr, (float*)smem);
      }
    }
    return;
  }
  if (ph == 1) {
    for (int it = bid; it < 65536 / 4; it += G) {
      const long tok = (long)it * 4 + wid;
      float4 v[4];
#pragma unroll
      for (int i = 0; i < 4; ++i) v[i] = *(const float4*)(p.x + tok * 1024 + i * 256 + lane * 4);
      float mu, rstd;
      ln_stats(v, mu, rstd);
      store_h(v, mu, rstd, p.f_mod() + (long)(tok >> 11) * 3072, p.f_h() + tok * LDH, lane);
    }
    return;
  }
}

DEVI void run_phase(const P& p, int ph) {
  char* smem = g_smem;
  const int tid = TID(), lane = tid & 63, wid = tid >> 6;
  const int G = gridDim.x, bid = blockIdx.x;
  const int q = ph - 2, gg = q / 12, l = (q % 12) / 6, k = q % 6;
  int* ctr = p.f_ctr() + (ph & 63);
  if (k == 0) {
    {
      const int x0 = (int)(xb_xcc_id() & 7u);
      int* c8 = p.f_ctr2() + (q / 6) * 8;
      for (int dd = 0; dd < 8; ++dd) {
        const int x = (x0 + dd) & 7;
        for (;;) {
          const int qq = next_item(c8 + x);
          if (qq >= 896) break;
          const int st = qq >> 6, within = qq & 63;
          P1Tile d;
          p1_desc2(p, gg, l, 16 * x + (st & 1) * 8 + (within & 7), (st >> 1) * 8 + (within >> 3), d);
          p1_tile2(p, d, smem);
        }
      }
    }
  } else if (k == 1) {
    constexpr int N0 = 1024, N1 = N0 + 1024, N2 = N1 + 768, N3 = N2 + 3072, N4 = N3 + 128;
    for (;;) {
      const int it = next_item(ctr);
      if (it >= N4) break;
      if (it < N0) b1_item(p, l, it, smem);
      else if (it < N1) { const int t = it - N0; p2_kvup_tile(p, gg, l, t >> 3, t & 7, smem); }
      else if (it < N2) { const int t = it - N1; p2_qup_tile(p, gg, l, t / 6, t % 6, smem); }
      else if (it < N3) attnD_item(p, it - N2, smem);
      else p2_kpe_item(p, gg, it - N3);
    }
  } else if (k == 2) {
    if (bid < (G >> 1))
    for (;;) {
      const int it = next_item(ctr);
      if (it >= 32) break;
      __builtin_amdgcn_s_setprio(3);
      b2_item(p, l, it, smem);
      __builtin_amdgcn_s_setprio(0);
    }
    {
      const int x0 = (int)(xb_xcc_id() & 7u);
      int* c8 = p.f_ctr2() + 64 + (q / 6) * 8;
      for (int dd = 0; dd < 8; ++dd) {
        const int x = (x0 + dd) & 7;
        for (;;) {
          const int i = next_item(c8 + x);
          if (i >= 256) break;
          if (i < 128) { const int bh = x + 8 * (i >> 5), qt = 31 - (i & 31); attnA_item(p, l, ((31 - qt) << 5) | bh, smem); }
          else { const int i2 = i - 128; const int bh = x + 8 * (i2 >> 4), qt = 15 - (i2 & 15); attnC_item(p, ((15 - qt) << 6) | bh, smem); }
        }
      }
    }
    for (;;) {
      const int it = next_item(ctr + 64);
      if (it >= 128) break;
      dcomb_item(p, it);
    }
  } else if (k == 3) {
    for (int it = bid; it < 1024; it += G) p4a_tile(p, l, it >> 3, it & 7, smem);
  } else if (k == 4) {
    for (int it = bid; it < 1024; it += G) p4b_tile(p, gg, l, it >> 3, it & 7, smem);
  } else {
    for (int it = bid; it < TG / 4; it += G) p4c_row(p, gg, l, (long)gg * TG + (long)it * 4 + wid, lane);
  }
}

__global__ void __launch_bounds__(256, 2) mega(P p, int ph_lo, int ph_hi) {
#if MULTI_LAUNCH
  run_phase(p, ph_lo);
#else
  cg::grid_group grid = cg::this_grid();
  __shared__ uint4 xb_words;
  if (threadIdx.x == 0) xb_words = make_uint4(0u, 0u, 0u, 0u);
  __syncthreads();
  XcdBarrier xb = xcd_barrier_post(p.f_bar(), (volatile LAS unsigned*)&xb_words);
  run_pre<0>(p); xcd_barrier(xb);
  run_pre<1>(p); xcd_barrier(xb);
  for (int ph = ph_lo + 2; ph < ph_hi; ++ph) {
    run_phase(p, ph);
    if (ph + 1 < ph_hi) {
      if (ph_hi < 0) grid.sync();
      xcd_barrier(xb);
    }
  }
#endif
}

extern "C" void kernel_launch(void* const* d_in, const int* in_sizes, int n_in, void* d_out, int out_size, void* d_ws, size_t ws_size,
                              hipStream_t stream) {
  P p{};
  p.x = (const float*)d_in[0]; p.c = (const float*)d_in[1]; p.pos = (const int*)d_in[2];
  p.w_ada = (const float*)d_in[3]; p.b_ada = (const float*)d_in[4]; p.w_in = (const float*)d_in[5]; p.conv_b = (const float*)d_in[6];
  p.a_log = (const float*)d_in[7]; p.dt_bias = (const float*)d_in[8]; p.out_norm_b = (const float*)d_in[9];
  p.lq1 = (const float*)d_in[10]; p.lk1 = (const float*)d_in[11]; p.lq2 = (const float*)d_in[12]; p.lk2 = (const float*)d_in[13];
  p.subln_g = (const float*)d_in[14]; p.q_norm_c = (const float*)d_in[15]; p.w_uq = (const float*)d_in[16]; p.kv_norm_c = (const float*)d_in[17];
  p.w_ukv = (const float*)d_in[18]; p.w_br = (const float*)d_in[19]; p.w_out = (const float*)d_in[20]; p.ln_g = (const float*)d_in[21];
  p.ln_b = (const float*)d_in[22];
  p.out = (float*)d_out;
  p.ws = (char*)d_ws;
  if (WS_TOTAL > ws_size) { fprintf(stderr, "workspace too small: need %zu have %zu\n", (size_t)WS_TOTAL, ws_size); return; }
#if MULTI_LAUNCH
  for (int ph = 0; ph < NPHASE; ++ph) hipLaunchKernelGGL(mega, dim3(512), dim3(256), 0, stream, p, ph, ph + 1);
#else
  static int grid_blocks = 0;
  if (!grid_blocks) {
    int dev = 0, cus = 0, per_cu = 0;
    hipGetDevice(&dev);
    hipDeviceGetAttribute(&cus, hipDeviceAttributeMultiprocessorCount, dev);
    hipOccupancyMaxActiveBlocksPerMultiprocessor(&per_cu, mega, 256, 0);
    if (per_cu > 2) per_cu = 2;
    grid_blocks = cus * per_cu;
    grid_blocks &= ~7;
    if (grid_blocks < 8) grid_blocks = 8;
  }
  int lo = 0, hi = NPHASE;
  void* args[] = {&p, &lo, &hi};
  (void)hipMemsetAsync((char*)d_ws + WS_BAR_OFF, 0, XCD_BAR_WORDS * 4, stream);
  hipError_t e = hipLaunchCooperativeKernel((void*)mega, dim3(grid_blocks), dim3(256), args, 0, stream);
  if (e != hipSuccess) fprintf(stderr, "cooperative launch failed: %s (grid %d)\n", hipGetErrorString(e), grid_blocks);
#endif
}
```

```cpp
#include <hip/hip_runtime.h>
#include <hip/hip_cooperative_groups.h>
#include <cstdio>
#include <cstdint>
namespace cg = cooperative_groups;

#ifndef MULTI_LAUNCH
#define MULTI_LAUNCH 0
#endif

typedef unsigned short bf16_t;
typedef short bf16x8 __attribute__((ext_vector_type(8)));
typedef float f32x4 __attribute__((ext_vector_type(4)));
typedef unsigned u32x4 __attribute__((ext_vector_type(4)));
typedef unsigned u32x2 __attribute__((ext_vector_type(2)));

#define DEVI __device__ __forceinline__

constexpr int S_ = 2048, DM = 1024, NBT = 32, NB = 8, NGRP = 4, TG = NB * S_;
constexpr int LDY = 14336;
constexpr int LDH = 1024 + 64, LDW = 1024 + 64;
constexpr int YA_Q = 0, YA_K = 512, YB_Q = 1536, YC = 3072, YKPE = 3456, YBETA = 3488, YDECAY = 3492,
              YD_Q = 3584, YD_K = 5120, YZ = 8192, YMG = 10240;
constexpr float EPS = 1e-6f;
constexpr float LOG2E = 1.4426950408889634f, LN2 = 0.6931471805599453f;
constexpr int SMEM_BYTES = 74240;
constexpr int NPHASE = 2 + NGRP * 2 * 6;

struct P {
  const float *x, *c; const int* pos;
  const float *w_ada, *b_ada, *w_in, *conv_b, *a_log, *dt_bias, *out_norm_b, *lq1, *lk1, *lq2, *lk2, *subln_g,
      *q_norm_c, *w_uq, *kv_norm_c, *w_ukv, *w_br, *w_out, *ln_g, *ln_b;
  float* out;
  char* ws;
  DEVI bf16_t* f_wInT() const { return (bf16_t*)(ws + 0ULL); }
  DEVI bf16_t* f_wUqT() const { return (bf16_t*)(ws + 62390272ULL); }
  DEVI bf16_t* f_wUkvT() const { return (bf16_t*)(ws + 63176704ULL); }
  DEVI bf16_t* f_wBrT() const { return (bf16_t*)(ws + 63700992ULL); }
  DEVI bf16_t* f_wOutT() const { return (bf16_t*)(ws + 72089600ULL); }
  DEVI float* f_mod() const { return (float*)(ws + 76283904ULL); }
  DEVI float2* f_ropeA() const { return (float2*)(ws + 77070336ULL); }
  DEVI float2* f_ropeC() const { return (float2*)(ws + 81264640ULL); }
  DEVI float* f_lam() const { return (float*)(ws + 89653248ULL); }
  DEVI int* f_ctr() const { return (int*)(ws + 89653504ULL); }
  DEVI int* f_ctr2() const { return (int*)(ws + 89654528ULL); }
  DEVI unsigned* f_bar() const { return (unsigned*)(ws + 89655552ULL); }
  DEVI bf16_t* f_h() const { return (bf16_t*)(ws + 89669376ULL); }
  DEVI bf16_t* f_Y() const { return (bf16_t*)(ws + 232275712ULL); }
  DEVI bf16_t* f_AvT() const { return (bf16_t*)(ws + 702037760ULL); }
  DEVI bf16_t* f_DvT() const { return (bf16_t*)(ws + 718814976ULL); }
  DEVI bf16_t* f_Qc() const { return (bf16_t*)(ws + 769146624ULL); }
  DEVI bf16_t* f_Kc() const { return (bf16_t*)(ws + 794312448ULL); }
  DEVI bf16_t* f_CvT() const { return (bf16_t*)(ws + 819478272ULL); }
  DEVI bf16_t* f_Do() const { return (bf16_t*)(ws + 836255488ULL); }
  DEVI float* f_Dlse() const { return (float*)(ws + 886587136ULL); }
  DEVI bf16_t* f_UT() const { return (bf16_t*)(ws + 888160000ULL); }
  DEVI bf16_t* f_Wm() const { return (bf16_t*)(ws + 904937216ULL); }
  DEVI bf16_t* f_QG() const { return (bf16_t*)(ws + 921714432ULL); }
  DEVI bf16_t* f_KGT() const { return (bf16_t*)(ws + 938491648ULL); }
  DEVI bf16_t* f_QKm() const { return (bf16_t*)(ws + 955268864ULL); }
  DEVI float* f_dlast() const { return (float*)(ws + 963657472ULL); }
  DEVI bf16_t* f_br() const { return (bf16_t*)(ws + 963661568ULL); }
  DEVI bf16_t* f_merged() const { return f_Do(); }
};
constexpr size_t WS_TOTAL = 1030770432ULL, WS_BAR_OFF = 89655552ULL;


DEVI int TID() { int t = threadIdx.x; asm volatile("" : "+v"(t)); return t; }
DEVI float bf2f(bf16_t b) { return __uint_as_float(((unsigned)b) << 16); }
DEVI bf16_t f2bf(float f) { unsigned u = __float_as_uint(f); u += 0x7fffu + ((u >> 16) & 1u); return (bf16_t)(u >> 16); }
typedef float f32x2_t __attribute__((ext_vector_type(2)));
typedef __bf16 bf16x2_t __attribute__((ext_vector_type(2)));
DEVI unsigned pk2(float lo, float hi) { f32x2_t v = {lo, hi}; bf16x2_t b = __builtin_convertvector(v, bf16x2_t); return __builtin_bit_cast(unsigned, b); }
DEVI float lo2f(unsigned u) { return __uint_as_float(u << 16); }
DEVI float hi2f(unsigned u) { return __uint_as_float(u & 0xffff0000u); }
DEVI f32x4 mma(bf16x8 a, bf16x8 b, f32x4 c) { return __builtin_amdgcn_mfma_f32_16x16x32_bf16(a, b, c, 0, 0, 0); }
DEVI float sigmf(float x) { return __builtin_amdgcn_rcpf(1.f + __builtin_amdgcn_exp2f(-1.4426950408889634f * x)); }
DEVI float siluf(float x) { return x * sigmf(x); }
DEVI float ex2(float x) { return __builtin_amdgcn_exp2f(x); }
DEVI bf16x8 ldfrag(const bf16_t* p) { return *(const bf16x8*)p; }

template <bool SWAP, int NT = 4>
DEVI void gemm_core(const bf16_t* __restrict__ A, long rs, const bf16_t* __restrict__ B, long ldb, int K,
                    f32x4 (&acc)[4][NT], bf16_t* sm) {
  const int tid = TID(), lane = tid & 63, wid = tid >> 6, g = lane >> 4, lr = lane & 15;
  const int wm = wid >> 1, wn = wid & 1;
  const int lrow = tid >> 3, lkc = (tid & 7) * 8;
  const int wsw = ((tid & 7) ^ ((lrow >> 1) & 7)) * 8;
  bf16_t* sA = sm; bf16_t* sB = sm + 2 * 128 * 64;
  const bf16_t* ap = A + (long)lrow * rs + lkc;
  const bf16_t* bp = B + (long)lrow * ldb + lkc;
  u32x4 ra0[4], rb0[NT], ra1[4], rb1[NT];
  const int nk = K >> 6;
#pragma unroll
  for (int i = 0; i < 4; ++i) ra0[i] = *(const u32x4*)(ap + (long)(32 * i) * rs);
#pragma unroll
  for (int i = 0; i < NT; ++i) rb0[i] = *(const u32x4*)(bp + (long)(32 * i) * ldb);
#pragma unroll
  for (int i = 0; i < 4; ++i) ra1[i] = *(const u32x4*)(ap + (long)(32 * i) * rs + 64);
#pragma unroll
  for (int i = 0; i < NT; ++i) rb1[i] = *(const u32x4*)(bp + (long)(32 * i) * ldb + 64);
#pragma unroll
  for (int i = 0; i < 4; ++i) *(u32x4*)&sA[(lrow + 32 * i) * 64 + wsw] = ra0[i];
#pragma unroll
  for (int i = 0; i < NT; ++i) *(u32x4*)&sB[(lrow + 32 * i) * 64 + wsw] = rb0[i];
  __syncthreads();
  const int f = (lr >> 1) & 7;
  const int rsw0 = (g ^ f) * 8, rsw1 = ((4 + g) ^ f) * 8;
  const bf16_t* cA0 = sA + (wm * 64 + lr) * 64;
  const bf16_t* cB0 = sB + (wn * NT * 16 + lr) * 64;
  auto compute = [&](int cur) {
    const bf16_t* cA = cA0 + cur * 128 * 64;
    const bf16_t* cB = cB0 + cur * 128 * 64;
#pragma unroll
    for (int ks = 0; ks < 2; ++ks) {
      const int rsw = ks ? rsw1 : rsw0;
      bf16x8 af[4];
#pragma unroll
      for (int t = 0; t < 4; ++t) af[t] = ldfrag(cA + t * 16 * 64 + rsw);
#pragma unroll
      for (int nt = 0; nt < NT; ++nt) {
        const bf16x8 bfr = ldfrag(cB + nt * 16 * 64 + rsw);
#pragma unroll
        for (int mt = 0; mt < 4; ++mt) {
          if (SWAP) acc[mt][nt] = mma(bfr, af[mt], acc[mt][nt]);
          else acc[mt][nt] = mma(af[mt], bfr, acc[mt][nt]);
        }
      }
    }
  };
  for (int kt = 0; kt < nk; kt += 2) {
    {
      const int kn = (kt + 2 < nk ? kt + 2 : nk - 1) * 64;
#pragma unroll
      for (int i = 0; i < 4; ++i) ra0[i] = *(const u32x4*)(ap + (long)(32 * i) * rs + kn);
#pragma unroll
      for (int i = 0; i < NT; ++i) rb0[i] = *(const u32x4*)(bp + (long)(32 * i) * ldb + kn);
    }
    compute(0);
    {
      bf16_t* nA = sA + 128 * 64; bf16_t* nB = sB + 128 * 64;
#pragma unroll
      for (int i = 0; i < 4; ++i) *(u32x4*)&nA[(lrow + 32 * i) * 64 + wsw] = ra1[i];
#pragma unroll
      for (int i = 0; i < NT; ++i) *(u32x4*)&nB[(lrow + 32 * i) * 64 + wsw] = rb1[i];
    }
    __syncthreads();
    {
      const int kn = (kt + 3 < nk ? kt + 3 : nk - 1) * 64;
#pragma unroll
      for (int i = 0; i < 4; ++i) ra1[i] = *(const u32x4*)(ap + (long)(32 * i) * rs + kn);
#pragma unroll
      for (int i = 0; i < NT; ++i) rb1[i] = *(const u32x4*)(bp + (long)(32 * i) * ldb + kn);
    }
    compute(1);
    if (kt + 2 < nk) {
#pragma unroll
      for (int i = 0; i < 4; ++i) *(u32x4*)&sA[(lrow + 32 * i) * 64 + wsw] = ra0[i];
#pragma unroll
      for (int i = 0; i < NT; ++i) *(u32x4*)&sB[(lrow + 32 * i) * 64 + wsw] = rb0[i];
    }
    __syncthreads();
  }
}

template <int NT>
DEVI void zero_acc(f32x4 (&acc)[4][NT]) {
#pragma unroll
  for (int i = 0; i < 4; ++i)
#pragma unroll
    for (int j = 0; j < NT; ++j) acc[i][j] = (f32x4){0.f, 0.f, 0.f, 0.f};
}

DEVI int src_col_win(int n) {
  if (n < 3072) return n;
  if (n < 3488) return 3080 + (n - 3072);
  if (n < 3496) return 3072 + (n - 3488);
  if (n < 3584) return -1;
  if (n < 8192) return 3496 + (n - 3584);
  if (n < 10240) return 8104 + (n - 8192);
  return 10152 + (n - 10240);
}

template <int MODE>
DEVI void tconv_tile(const float* __restrict__ src, int ldsrc, bf16_t* __restrict__ dst, int K, int n0, int k0,
                     const float* __restrict__ kscale, float* t) {
  const int tid = TID();
  const int kk = tid >> 4, nn = (tid & 15) * 4;
  const int n = n0 + nn;
  int sc;
  if (MODE == 0) sc = src_col_win(n);
  else if (MODE == 2) sc = (n < 512) ? ((n >> 6) * 128 + (n & 63)) : (((n - 512) >> 6) * 128 + 64 + ((n - 512) & 63));
  else sc = n;
#pragma unroll
  for (int i = 0; i < 4; ++i) {
    const int k = kk + 16 * i;
    float4 v = make_float4(0.f, 0.f, 0.f, 0.f);
    if (sc >= 0) v = *(const float4*)(src + (long)(k0 + k) * ldsrc + sc);
    if (kscale) { const float s = kscale[k0 + k]; v.x *= s; v.y *= s; v.z *= s; v.w *= s; }
    t[k * 65 + nn + 0] = v.x; t[k * 65 + nn + 1] = v.y; t[k * 65 + nn + 2] = v.z; t[k * 65 + nn + 3] = v.w;
  }
  __syncthreads();
  const int n2 = tid >> 2, kq = (tid & 3) * 16;
  u32x4 o0, o1;
  o0.x = pk2(t[(kq + 0) * 65 + n2], t[(kq + 1) * 65 + n2]); o0.y = pk2(t[(kq + 2) * 65 + n2], t[(kq + 3) * 65 + n2]);
  o0.z = pk2(t[(kq + 4) * 65 + n2], t[(kq + 5) * 65 + n2]); o0.w = pk2(t[(kq + 6) * 65 + n2], t[(kq + 7) * 65 + n2]);
  o1.x = pk2(t[(kq + 8) * 65 + n2], t[(kq + 9) * 65 + n2]); o1.y = pk2(t[(kq + 10) * 65 + n2], t[(kq + 11) * 65 + n2]);
  o1.z = pk2(t[(kq + 12) * 65 + n2], t[(kq + 13) * 65 + n2]); o1.w = pk2(t[(kq + 14) * 65 + n2], t[(kq + 15) * 65 + n2]);
  bf16_t* d = dst + (long)(n0 + n2) * K + k0 + kq;
  *(u32x4*)d = o0; *(u32x4*)(d + 8) = o1;
  __syncthreads();
}

DEVI void mod_item(const P& p, int item, char* smem) {
  const int l = item / 48, j0 = (item % 48) * 64;
  const int tid = TID(), kq = tid >> 6, j = tid & 63;
  float* cs = (float*)smem;
  float* red = cs + 4096;
  float acc[32];
#pragma unroll
  for (int b = 0; b < 32; ++b) acc[b] = 0.f;
  const float* w = p.w_ada + (long)l * 1024 * 3072 + j0 + j;
  for (int ch = 0; ch < 8; ++ch) {
#pragma unroll
    for (int i = 0; i < 16; ++i) {
      const int idx = tid + 256 * i;
      const int q = idx >> 10, b = (idx >> 5) & 31, kk = idx & 31;
      const float cv = p.c[b * 1024 + q * 256 + ch * 32 + kk];
      cs[idx] = siluf(cv);
    }
    __syncthreads();
#pragma unroll 1
    for (int kk4 = 0; kk4 < 8; ++kk4) {
      const int kb = kq * 256 + ch * 32 + kk4 * 4;
      const float w0 = w[(long)(kb + 0) * 3072], w1 = w[(long)(kb + 1) * 3072], w2 = w[(long)(kb + 2) * 3072], w3 = w[(long)(kb + 3) * 3072];
#pragma unroll
      for (int b = 0; b < 32; ++b) {
        const float4 cv = *(const float4*)&cs[(kq * 32 + b) * 32 + kk4 * 4];
        acc[b] += cv.x * w0 + cv.y * w1 + cv.z * w2 + cv.w * w3;
      }
    }
    __syncthreads();
  }
#pragma unroll
  for (int b = 0; b < 32; ++b) red[(kq * 32 + b) * 64 + j] = acc[b];
  __syncthreads();
#pragma unroll
  for (int i = 0; i < 8; ++i) {
    const int idx = tid + 256 * i;
    const int b = idx >> 6, jj = idx & 63;
    const float v = red[(0 * 32 + b) * 64 + jj] + red[(1 * 32 + b) * 64 + jj] + red[(2 * 32 + b) * 64 + jj] + red[(3 * 32 + b) * 64 + jj] +
                    p.b_ada[l * 3072 + j0 + jj];
    p.f_mod()[(long)(l * 32 + b) * 3072 + j0 + jj] = v;
  }
  __syncthreads();
}

DEVI void rope_item(const P& p, int item) {
  const int t = item * 256 + TID();
  const float pos = (float)p.pos[t];
  const double L2T = 18.931568569324174;
  const double INV2PI = 0.15915494309189535;
#pragma unroll
  for (int i = 0; i < 8; ++i) {
    const float invf = (float)exp2(-(double)i * L2T / 8.0);
    const float ang = pos * invf;
    const double rev = (double)ang * INV2PI;
    const float fr = (float)(rev - floor(rev));
    p.f_ropeA()[(long)t * 8 + i] = make_float2(__builtin_amdgcn_cosf(fr), __builtin_amdgcn_sinf(fr));
  }
#pragma unroll
  for (int i = 0; i < 16; ++i) {
    const float invf = (float)exp2(-(double)i * L2T / 16.0);
    const float ang = pos * invf;
    const double rev = (double)ang * INV2PI;
    const float fr = (float)(rev - floor(rev));
    p.f_ropeC()[(long)t * 16 + i] = make_float2(__builtin_amdgcn_cosf(fr), __builtin_amdgcn_sinf(fr));
  }
}

DEVI float wave_sum(float v) {
#pragma unroll
  for (int o = 32; o >= 1; o >>= 1) v += __shfl_xor(v, o);
  return v;
}

DEVI void ln_stats(const float4 (&v)[4], float& mu, float& rstd) {
  float s = 0.f;
#pragma unroll
  for (int i = 0; i < 4; ++i) s += (v[i].x + v[i].y) + (v[i].z + v[i].w);
  mu = wave_sum(s) * (1.f / 1024.f);
  float q = 0.f;
#pragma unroll
  for (int i = 0; i < 4; ++i) { const float a = v[i].x - mu, b = v[i].y - mu, c = v[i].z - mu, d = v[i].w - mu; q += (a * a + b * b) + (c * c + d * d); }
  rstd = rsqrtf(wave_sum(q) * (1.f / 1024.f) + EPS);
}

DEVI void store_h(const float4 (&v)[4], float mu, float rstd, const float* __restrict__ modb, bf16_t* __restrict__ hr, int lane) {
#pragma unroll
  for (int i = 0; i < 4; ++i) {
    const int col = i * 256 + lane * 4;
    const float4 sh = *(const float4*)(modb + col), sc = *(const float4*)(modb + 1024 + col);
    const float a = (v[i].x - mu) * rstd * (1.f + sc.x) + sh.x, b = (v[i].y - mu) * rstd * (1.f + sc.y) + sh.y;
    const float c = (v[i].z - mu) * rstd * (1.f + sc.z) + sh.z, d = (v[i].w - mu) * rstd * (1.f + sc.w) + sh.w;
    u32x2 o; o.x = pk2(a, b); o.y = pk2(c, d);
    *(u32x2*)(hr + col) = o;
  }
}

struct P1Tile { const bf16_t* A; long rs; const bf16_t* B; long tokbase; int bl, j, n0, gi, dl, res, ib; bool vt; };

DEVI void p1_desc(const P& p, int gg, int l, int mtile, int ntile, P1Tile& d) {
  d.bl = mtile >> 4; d.j = mtile & 15; d.n0 = ntile * 128;
  const bool segD = (d.n0 >= 3584 && d.n0 < 8192);
  d.dl = 1; d.gi = 0;
  if (segD) { d.gi = ((d.n0 - 3584) % 1536) / 512; d.dl = d.gi == 0 ? 1 : (d.gi == 1 ? 4 : 16); }
  const int nrb = 16 / d.dl;
  d.res = d.j / nrb; d.ib = d.j % nrb;
  d.tokbase = (long)gg * TG + d.bl * 2048;
  d.A = p.f_h() + (d.tokbase + (long)d.ib * 128 * d.dl + d.res) * LDH;
  d.rs = (long)d.dl * LDH;
  d.B = p.f_wInT() + ((long)l * LDY + d.n0) * LDW;
  d.vt = (d.n0 >= 1024 && d.n0 < 1536) || (d.n0 >= 6656 && d.n0 < 8192);
}

template <bool SWAP>
DEVI void gemm_stream(const bf16_t* __restrict__ ap, long rs, const bf16_t* __restrict__ bp,
                      const bf16_t* __restrict__ nap, long nrs, const bf16_t* __restrict__ nbp,
                      u32x4 (&ra0)[4], u32x4 (&rb0)[4], u32x4 (&ra1)[4], u32x4 (&rb1)[4], f32x4 (&acc)[4][4], bf16_t* sm) {
  const int tid = TID(), lane = tid & 63, wid = tid >> 6, g = lane >> 4, lr = lane & 15;
  const int wm = wid >> 1, wn = wid & 1;
  const int lrow = tid >> 3, lkc = (tid & 7) * 8;
  const int wsw = ((tid & 7) ^ ((lrow >> 1) & 7)) * 8;
  const unsigned voa = (unsigned)(lrow * (int)rs + lkc) * 2u, vona = (unsigned)(lrow * (int)nrs + lkc) * 2u, vob = (unsigned)(lrow * LDW + lkc) * 2u;
  bf16_t* sA = sm; bf16_t* sB = sm + 2 * 128 * 64;
#pragma unroll
  for (int i = 0; i < 4; ++i) *(u32x4*)&sA[(lrow + 32 * i) * 64 + wsw] = ra0[i];
#pragma unroll
  for (int i = 0; i < 4; ++i) *(u32x4*)&sB[(lrow + 32 * i) * 64 + wsw] = rb0[i];
  __syncthreads();
  const int f = (lr >> 1) & 7;
  const int rsw0 = (g ^ f) * 8, rsw1 = ((4 + g) ^ f) * 8;
  const bf16_t* cA0 = sA + (wm * 64 + lr) * 64;
  const bf16_t* cB0 = sB + (wn * 64 + lr) * 64;
  auto compute = [&](int cur) {
    const bf16_t* cA = cA0 + cur * 128 * 64;
    const bf16_t* cB = cB0 + cur * 128 * 64;
#pragma unroll
    for (int ks = 0; ks < 2; ++ks) {
      const int rsw = ks ? rsw1 : rsw0;
      bf16x8 af[4];
#pragma unroll
      for (int t = 0; t < 4; ++t) af[t] = ldfrag(cA + t * 16 * 64 + rsw);
#pragma unroll
      for (int nt = 0; nt < 4; ++nt) {
        const bf16x8 bfr = ldfrag(cB + nt * 16 * 64 + rsw);
#pragma unroll
        for (int mt = 0; mt < 4; ++mt) {
          if (SWAP) acc[mt][nt] = mma(bfr, af[mt], acc[mt][nt]);
          else acc[mt][nt] = mma(af[mt], bfr, acc[mt][nt]);
        }
      }
    }
  };
#pragma unroll 1
  for (int kt = 0; kt < 16; kt += 2) {
    {
      const bool tail = (kt + 2 >= 16);
      const bf16_t* a_ = tail ? nap : ap + (kt + 2) * 64;
      const bf16_t* b_ = tail ? nbp : bp + (kt + 2) * 64;
      const long rs_ = tail ? nrs : rs;
      const unsigned va_ = tail ? vona : voa;
#pragma unroll
      for (int i = 0; i < 4; ++i) ra0[i] = *(const u32x4*)((const char*)(a_ + (long)(32 * i) * rs_) + va_);
#pragma unroll
      for (int i = 0; i < 4; ++i) rb0[i] = *(const u32x4*)((const char*)(b_ + (long)(32 * i) * LDW) + vob);
    }
    compute(0);
    {
      bf16_t* nA = sA + 128 * 64; bf16_t* nB = sB + 128 * 64;
#pragma unroll
      for (int i = 0; i < 4; ++i) *(u32x4*)&nA[(lrow + 32 * i) * 64 + wsw] = ra1[i];
#pragma unroll
      for (int i = 0; i < 4; ++i) *(u32x4*)&nB[(lrow + 32 * i) * 64 + wsw] = rb1[i];
    }
    __syncthreads();
    {
      const bool tail = (kt + 3 >= 16);
      const bf16_t* a_ = tail ? nap + 64 : ap + (kt + 3) * 64;
      const bf16_t* b_ = tail ? nbp + 64 : bp + (kt + 3) * 64;
      const long rs_ = tail ? nrs : rs;
      const unsigned va_ = tail ? vona : voa;
#pragma unroll
      for (int i = 0; i < 4; ++i) ra1[i] = *(const u32x4*)((const char*)(a_ + (long)(32 * i) * rs_) + va_);
#pragma unroll
      for (int i = 0; i < 4; ++i) rb1[i] = *(const u32x4*)((const char*)(b_ + (long)(32 * i) * LDW) + vob);
    }
    compute(1);
    if (kt + 2 < 16) {
#pragma unroll
      for (int i = 0; i < 4; ++i) *(u32x4*)&sA[(lrow + 32 * i) * 64 + wsw] = ra0[i];
#pragma unroll
      for (int i = 0; i < 4; ++i) *(u32x4*)&sB[(lrow + 32 * i) * 64 + wsw] = rb0[i];
    }
    __syncthreads();
  }
}

DEVI void p1_epilogue(const P& p, const P1Tile& d, f32x4 (&acc)[4][4], char* smem) {
  const int tid = TID(), lane = tid & 63, wid = tid >> 6, g = lane >> 4, lr = lane & 15;
  const int wm = wid >> 1, wn = wid & 1;
  const int bl = d.bl, j = d.j, n0 = d.n0, gi = d.gi, dl = d.dl, res = d.res, ib = d.ib;
  const long tokbase = d.tokbase;
  bf16_t* T = (bf16_t*)smem;
  if (d.vt) {
#pragma unroll
    for (int mt = 0; mt < 4; ++mt)
#pragma unroll
      for (int nt = 0; nt < 4; ++nt) {
        const int i0 = wm * 64 + mt * 16 + g * 4;
        const int nl = wn * 64 + nt * 16 + lr;
        u32x2 o; o.x = pk2(acc[mt][nt][0], acc[mt][nt][1]); o.y = pk2(acc[mt][nt][2], acc[mt][nt][3]);
        *(u32x2*)&T[nl * 136 + i0] = o;
      }
    __syncthreads();
#pragma unroll 2
    for (int i = 0; i < 8; ++i) {
      const int c = tid + 256 * i, row = c >> 4, cc = c & 15;
      const u32x4 v = *(const u32x4*)&T[row * 136 + cc * 8];
      const int n = n0 + row;
      bf16_t* dst;
      if (n0 < 1536) { const int cs = n - 1024; dst = p.f_AvT() + ((long)((bl * 4 + (cs >> 7)) * 128 + (cs & 127))) * 2048; }
      else { const int cs = n - 6656 - gi * 512; dst = p.f_DvT() + ((long)(((gi * 8 + bl) * 8 + (cs >> 6)) * 64 + (cs & 63))) * 2048; }
      __builtin_nontemporal_store(v, (u32x4*)(dst + j * 128 + cc * 8));
    }
    __syncthreads();
  } else {
    const bool rope = (n0 < 1024) || (n0 >= 3584 && n0 < 6656);
    const bool sg = (n0 >= YMG);
#pragma unroll
    for (int mt = 0; mt < 4; ++mt) {
      const int i = wm * 64 + mt * 16 + lr;
      const int s = (ib * 128 + i) * dl + res;
#pragma unroll
      for (int nt = 0; nt < 4; ++nt) {
        f32x4 v = acc[mt][nt];
        if (nt == 0 && rope) {
          const float2* tb = p.f_ropeA() + (tokbase + s) * 8 + (g & 1) * 4;
#pragma unroll
          for (int r = 0; r < 4; ++r) {
            const float pv = __shfl_xor(v[r], 32);
            const float2 cs = tb[r];
            v[r] = (g < 2) ? (v[r] * cs.x - pv * cs.y) : (v[r] * cs.x + pv * cs.y);
          }
        }
        if (sg) {
#pragma unroll
          for (int r = 0; r < 4; ++r) v[r] = sigmf(v[r]);
        }
        u32x2 o; o.x = pk2(v[0], v[1]); o.y = pk2(v[2], v[3]);
        *(u32x2*)&T[i * 136 + wn * 64 + nt * 16 + g * 4] = o;
      }
    }
    __syncthreads();
    bf16_t* ybase = p.f_Y() + ((long)(bl * 2048 + j * 128)) * LDY + n0;
#pragma unroll 2
    for (int i = 0; i < 8; ++i) {
      const int c = tid + 256 * i, row = c >> 4, cc = c & 15;
      __builtin_nontemporal_store(*(const u32x4*)&T[row * 136 + cc * 8], (u32x4*)(ybase + (long)row * LDY + cc * 8));
    }
    __syncthreads();
  }
}


template <bool SWAP>
DEVI void gemm_big(const bf16_t* __restrict__ A, long rs, const bf16_t* __restrict__ B, f32x4 (&acc)[4][8], bf16_t* sm) {
  const int tid = TID(), lane = tid & 63, wid = tid >> 6, g = lane >> 4, lr = lane & 15;
  const int wm = wid >> 1, wn = wid & 1;
  const int lrow = tid >> 3, lkc = (tid & 7) * 8;
  const int wsw = ((tid & 7) ^ ((lrow >> 1) & 7)) * 8;
  const unsigned voa = (unsigned)(lrow * (int)rs + lkc) * 2u, vob = (unsigned)(lrow * LDW + lkc) * 2u;
  bf16_t* sA = sm; bf16_t* sB = sm + 128 * 64;
  u32x4 ra[4], rb[8];
#pragma unroll
  for (int i = 0; i < 4; ++i) ra[i] = *(const u32x4*)((const char*)(A + (long)(32 * i) * rs) + voa);
#pragma unroll
  for (int i = 0; i < 8; ++i) rb[i] = *(const u32x4*)((const char*)(B + (long)(32 * i) * LDW) + vob);
  const int f = (lr >> 1) & 7;
  const int rsw0 = (g ^ f) * 8, rsw1 = ((4 + g) ^ f) * 8;
  const bf16_t* cA = sA + (wm * 64 + lr) * 64;
  const bf16_t* cB = sB + (wn * 128 + lr) * 64;
#pragma unroll 1
  for (int kt = 0; kt < 16; ++kt) {
#pragma unroll
    for (int i = 0; i < 4; ++i) *(u32x4*)&sA[(lrow + 32 * i) * 64 + wsw] = ra[i];
#pragma unroll
    for (int i = 0; i < 8; ++i) *(u32x4*)&sB[(lrow + 32 * i) * 64 + wsw] = rb[i];
    __syncthreads();
    {
      const int kn = (kt + 1 < 16 ? kt + 1 : 15) * 64;
#pragma unroll
      for (int i = 0; i < 4; ++i) ra[i] = *(const u32x4*)((const char*)(A + (long)(32 * i) * rs + kn) + voa);
#pragma unroll
      for (int i = 0; i < 8; ++i) rb[i] = *(const u32x4*)((const char*)(B + (long)(32 * i) * LDW + kn) + vob);
    }
#pragma unroll
    for (int ks = 0; ks < 2; ++ks) {
      const int rsw = ks ? rsw1 : rsw0;
      bf16x8 af[4];
#pragma unroll
      for (int t = 0; t < 4; ++t) af[t] = ldfrag(cA + t * 16 * 64 + rsw);
#pragma unroll
      for (int nt = 0; nt < 8; ++nt) {
        const bf16x8 bfr = ldfrag(cB + nt * 16 * 64 + rsw);
#pragma unroll
        for (int mt = 0; mt < 4; ++mt) {
          if (SWAP) acc[mt][nt] = mma(bfr, af[mt], acc[mt][nt]);
          else acc[mt][nt] = mma(af[mt], bfr, acc[mt][nt]);
        }
      }
    }
    __syncthreads();
  }
}

DEVI void p1_desc2(const P& p, int gg, int l, int mtile, int ntile, P1Tile& d) {
  d.bl = mtile >> 4; d.j = mtile & 15; d.n0 = ntile * 256;
  const bool segD = (d.n0 >= 3584 && d.n0 < 8192);
  d.dl = 1; d.gi = 0;
  if (segD) { d.gi = ((d.n0 - 3584) % 1536) / 512; d.dl = d.gi == 0 ? 1 : (d.gi == 1 ? 4 : 16); }
  const int nrb = 16 / d.dl;
  d.res = d.j / nrb; d.ib = d.j % nrb;
  d.tokbase = (long)gg * TG + d.bl * 2048;
  d.A = p.f_h() + (d.tokbase + (long)d.ib * 128 * d.dl + d.res) * LDH;
  d.rs = (long)d.dl * LDH;
  d.B = p.f_wInT() + ((long)l * LDY + d.n0) * LDW;
  d.vt = (d.n0 >= 1024 && d.n0 < 1536) || (d.n0 >= 6656 && d.n0 < 8192);
}

DEVI void p1_tile2(const P& p, const P1Tile& d, char* smem) {
  const int tid = TID(), lane = tid & 63, wid = tid >> 6, g = lane >> 4, lr = lane & 15;
  const int wm = wid >> 1, wn = wid & 1;
  const int bl = d.bl, j = d.j, n0 = d.n0, gi = d.gi, dl = d.dl, res = d.res, ib = d.ib;
  const long tokbase = d.tokbase;
  bf16_t* T = (bf16_t*)smem;
  f32x4 acc[4][8];
#pragma unroll
  for (int a = 0; a < 4; ++a)
#pragma unroll
    for (int b = 0; b < 8; ++b) acc[a][b] = (f32x4){0.f, 0.f, 0.f, 0.f};
  if (d.vt) {
    gemm_big<false>(d.A, d.rs, d.B, acc, (bf16_t*)smem);
#pragma unroll
    for (int mt = 0; mt < 4; ++mt)
#pragma unroll
      for (int nt = 0; nt < 8; ++nt) {
        const int i0 = wm * 64 + mt * 16 + g * 4;
        const int nl = wn * 128 + nt * 16 + lr;
        u32x2 o; o.x = pk2(acc[mt][nt][0], acc[mt][nt][1]); o.y = pk2(acc[mt][nt][2], acc[mt][nt][3]);
        *(u32x2*)&T[nl * 136 + i0] = o;
      }
    __syncthreads();
#pragma unroll 2
    for (int i = 0; i < 16; ++i) {
      const int c = tid + 256 * i, row = c >> 4, cc = c & 15;
      const u32x4 v = *(const u32x4*)&T[row * 136 + cc * 8];
      const int n = n0 + row;
      bf16_t* dst;
      if (n0 < 1536) { const int cs = n - 1024; dst = p.f_AvT() + ((long)((bl * 4 + (cs >> 7)) * 128 + (cs & 127))) * 2048; }
      else { const int cs = n - 6656 - gi * 512; dst = p.f_DvT() + ((long)(((gi * 8 + bl) * 8 + (cs >> 6)) * 64 + (cs & 63))) * 2048; }
      __builtin_nontemporal_store(v, (u32x4*)(dst + j * 128 + cc * 8));
    }
    __syncthreads();
  } else {
    gemm_big<true>(d.A, d.rs, d.B, acc, (bf16_t*)smem);
    const bool rope = (n0 < 1024) || (n0 >= 3584 && n0 < 6656);
    const bool sg = (n0 >= YMG);
#pragma unroll
    for (int mt = 0; mt < 4; ++mt) {
      const int i = wm * 64 + mt * 16 + lr;
      const int s = (ib * 128 + i) * dl + res;
#pragma unroll
      for (int nt = 0; nt < 8; ++nt) {
        f32x4 v = acc[mt][nt];
        if ((nt & 3) == 0 && rope) {
          const float2* tb = p.f_ropeA() + (tokbase + s) * 8 + (g & 1) * 4;
#pragma unroll
          for (int r = 0; r < 4; ++r) {
            const float pv = __shfl_xor(v[r], 32);
            const float2 cs = tb[r];
            v[r] = (g < 2) ? (v[r] * cs.x - pv * cs.y) : (v[r] * cs.x + pv * cs.y);
          }
        }
        if (sg) {
#pragma unroll
          for (int r = 0; r < 4; ++r) v[r] = sigmf(v[r]);
        }
        u32x2 o; o.x = pk2(v[0], v[1]); o.y = pk2(v[2], v[3]);
        *(u32x2*)&T[i * 264 + wn * 128 + nt * 16 + g * 4] = o;
      }
    }
    __syncthreads();
    bf16_t* ybase = p.f_Y() + ((long)(bl * 2048 + j * 128)) * LDY + n0;
#pragma unroll 2
    for (int i = 0; i < 16; ++i) {
      const int c = tid + 256 * i, row = c >> 5, cc = c & 31;
      __builtin_nontemporal_store(*(const u32x4*)&T[row * 264 + cc * 8], (u32x4*)(ybase + (long)row * LDY + cc * 8));
    }
    __syncthreads();
  }
}

DEVI void rowscale_prepass(const bf16_t* __restrict__ A, long rs, int K, float* rsl) {
  const int tid = TID(), row = tid >> 1, half = tid & 1;
  const bf16_t* ap = A + (long)row * rs + half * (K >> 1);
  float ss = 0.f;
  for (int c = 0; c < (K >> 4); ++c) {
    const u32x4 u = *(const u32x4*)(ap + c * 8);
    ss += lo2f(u.x) * lo2f(u.x) + hi2f(u.x) * hi2f(u.x) + lo2f(u.y) * lo2f(u.y) + hi2f(u.y) * hi2f(u.y) +
          lo2f(u.z) * lo2f(u.z) + hi2f(u.z) * hi2f(u.z) + lo2f(u.w) * lo2f(u.w) + hi2f(u.w) * hi2f(u.w);
  }
  ss += __shfl_xor(ss, 1);
  if (half == 0) rsl[row] = rsqrtf(ss / (float)K + EPS);
  __syncthreads();
}

DEVI void p2_qup_tile(const P& p, int gg, int l, int mtile, int ntile, char* smem) {
  const int tid = TID(), lane = tid & 63, wid = tid >> 6, g = lane >> 4, lr = lane & 15;
  const int wm = wid >> 1, wn = wid & 1;
  float* rsl = (float*)(smem + 73728);
  const bf16_t* A = p.f_Y() + (long)(mtile * 128) * LDY + YC;
  rowscale_prepass(A, LDY, 256, rsl);
  f32x4 acc[4][4];
  zero_acc(acc);
  gemm_core<true>(A, LDY, p.f_wUqT() + ((long)l * 768 + ntile * 128) * 256, 256, 256, acc, (bf16_t*)smem);
#pragma unroll
  for (int mt = 0; mt < 4; ++mt) {
    const int i = wm * 64 + mt * 16 + lr;
    const int tokl = mtile * 128 + i;
    const float rsv = rsl[i];
    const float2* tb = p.f_ropeC() + ((long)gg * TG + tokl) * 16 + g * 4;
#pragma unroll
    for (int nt = 0; nt < 4; ++nt) {
      const int colb = ntile * 128 + wn * 64 + nt * 16;
      const int cc = colb % 96;
      f32x4 v = acc[mt][nt] * rsv;
      if (cc == 64) {
        const f32x4 pv = acc[mt][(nt + 1) & 3] * rsv;
#pragma unroll
        for (int r = 0; r < 4; ++r) { const float2 cs = tb[r]; v[r] = v[r] * cs.x - pv[r] * cs.y; }
      } else if (cc == 80) {
        const f32x4 pv = acc[mt][(nt + 3) & 3] * rsv;
#pragma unroll
        for (int r = 0; r < 4; ++r) { const float2 cs = tb[r]; v[r] = v[r] * cs.x + pv[r] * cs.y; }
      }
      u32x2 o; o.x = pk2(v[0], v[1]); o.y = pk2(v[2], v[3]);
      *(u32x2*)(p.f_Qc() + (long)tokl * 768 + colb + g * 4) = o;
    }
  }
  __syncthreads();
}

DEVI void p2_kvup_tile(const P& p, int gg, int l, int mtile, int ntile, char* smem) {
  const int tid = TID(), lane = tid & 63, wid = tid >> 6, g = lane >> 4, lr = lane & 15;
  const int wm = wid >> 1, wn = wid & 1;
  float* rsl = (float*)(smem + 73728);
  const bf16_t* A = p.f_Y() + (long)(mtile * 128) * LDY + YC + 256;
  rowscale_prepass(A, LDY, 128, rsl);
  f32x4 acc[4][4];
  zero_acc(acc);
  const bf16_t* B = p.f_wUkvT() + ((long)l * 1024 + ntile * 128) * 128;
  if (ntile < 4) {
    gemm_core<true>(A, LDY, B, 128, 128, acc, (bf16_t*)smem);
#pragma unroll
    for (int mt = 0; mt < 4; ++mt) {
      const int i = wm * 64 + mt * 16 + lr;
      const int tokl = mtile * 128 + i;
      const float rsv = rsl[i];
#pragma unroll
      for (int nt = 0; nt < 4; ++nt) {
        const int n = ntile * 128 + wn * 64 + nt * 16 + g * 4;
        const f32x4 v = acc[mt][nt] * rsv;
        u32x2 o; o.x = pk2(v[0], v[1]); o.y = pk2(v[2], v[3]);
        *(u32x2*)(p.f_Kc() + (long)tokl * 768 + (n >> 6) * 96 + (n & 63)) = o;
      }
    }
  } else {
    gemm_core<false>(A, LDY, B, 128, 128, acc, (bf16_t*)smem);
    const int bl = mtile >> 4, j = mtile & 15;
#pragma unroll
    for (int mt = 0; mt < 4; ++mt) {
      const int i0 = wm * 64 + mt * 16 + g * 4;
      const float r0 = rsl[i0], r1 = rsl[i0 + 1], r2 = rsl[i0 + 2], r3 = rsl[i0 + 3];
#pragma unroll
      for (int nt = 0; nt < 4; ++nt) {
        const int n = (ntile - 4) * 128 + wn * 64 + nt * 16 + lr;
        u32x2 o; o.x = pk2(acc[mt][nt][0] * r0, acc[mt][nt][1] * r1); o.y = pk2(acc[mt][nt][2] * r2, acc[mt][nt][3] * r3);
        *(u32x2*)(p.f_CvT() + ((long)((bl * 8 + (n >> 6)) * 64 + (n & 63))) * 2048 + j * 128 + i0) = o;
      }
    }
  }
  __syncthreads();
}

DEVI void p2_kpe_item(const P& p, int gg, int item) {
  const int tid = TID();
  const int tokl = item * 128 + (tid >> 1), i0 = (tid & 1) * 8;
  const bf16_t* src = p.f_Y() + (long)tokl * LDY + YKPE;
  const u32x4 a = *(const u32x4*)(src + i0), b = *(const u32x4*)(src + 16 + i0);
  const float2* tb = p.f_ropeC() + ((long)gg * TG + tokl) * 16 + i0;
  float x1[8] = {lo2f(a.x), hi2f(a.x), lo2f(a.y), hi2f(a.y), lo2f(a.z), hi2f(a.z), lo2f(a.w), hi2f(a.w)};
  float x2[8] = {lo2f(b.x), hi2f(b.x), lo2f(b.y), hi2f(b.y), lo2f(b.z), hi2f(b.z), lo2f(b.w), hi2f(b.w)};
  float y1[8], y2[8];
#pragma unroll
  for (int i = 0; i < 8; ++i) { const float2 cs = tb[i]; y1[i] = x1[i] * cs.x - x2[i] * cs.y; y2[i] = x2[i] * cs.x + x1[i] * cs.y; }
  u32x4 o1, o2;
  o1.x = pk2(y1[0], y1[1]); o1.y = pk2(y1[2], y1[3]); o1.z = pk2(y1[4], y1[5]); o1.w = pk2(y1[6], y1[7]);
  o2.x = pk2(y2[0], y2[1]); o2.y = pk2(y2[2], y2[3]); o2.z = pk2(y2[4], y2[5]); o2.w = pk2(y2[6], y2[7]);
#pragma unroll
  for (int hh = 0; hh < 8; ++hh) {
    bf16_t* d = p.f_Kc() + (long)tokl * 768 + hh * 96 + 64 + i0;
    *(u32x4*)d = o1; *(u32x4*)(d + 16) = o2;
  }
}

template <int DQK, int NMAP, int DV, int QT>
DEVI void attn_core(const bf16_t* __restrict__ Q, long ldq, const bf16_t* __restrict__ Kb, long ldk,
                    const bf16_t* __restrict__ VT, long ldv, int kt_lo, int kt_hi, int q0, int win, float scale2,
                    f32x4 (&O)[QT][NMAP][DV / 16], float (&mrun)[QT][NMAP], float (&lrun)[QT][NMAP], bf16_t* sm) {
  constexpr int KC = NMAP * DQK, NKS = DQK / 32, NDT = DV / 16;
  constexpr int KCPR = KC / 8;
  constexpr int KST = (KC > 64) ? 128 : 64;
  constexpr int KXM = (KC > 64) ? 15 : 7;
  constexpr int KCH = 64 * KCPR / 256, VCH = DV * 8 / 256;
  bf16_t* Ks = sm; bf16_t* Vs = sm + 64 * KST;
  const int tid = TID(), lane = tid & 63, wid = tid >> 6, g = lane >> 4, lr = lane & 15;
  bf16x8 qf[QT][NMAP][NKS];
#pragma unroll
  for (int qi = 0; qi < QT; ++qi) {
    const bf16_t* qrow = Q + (long)(qi * 64 + wid * 16 + lr) * ldq;
#pragma unroll
    for (int m = 0; m < NMAP; ++m)
#pragma unroll
      for (int ks = 0; ks < NKS; ++ks) qf[qi][m][ks] = ldfrag(qrow + m * DQK + ks * 32 + g * 8);
  }
#pragma unroll
  for (int qi = 0; qi < QT; ++qi)
#pragma unroll
    for (int m = 0; m < NMAP; ++m) {
      mrun[qi][m] = -1e30f; lrun[qi][m] = 0.f;
#pragma unroll
      for (int dt = 0; dt < NDT; ++dt) O[qi][m][dt] = (f32x4){0.f, 0.f, 0.f, 0.f};
    }
  u32x4 rk[KCH], rv[VCH];
#pragma unroll
  for (int i = 0; i < KCH; ++i) { const int c = tid + 256 * i; rk[i] = *(const u32x4*)(Kb + (long)(kt_lo * 64 + c / KCPR) * ldk + (c % KCPR) * 8); }
#pragma unroll
  for (int i = 0; i < VCH; ++i) { const int c = tid + 256 * i; rv[i] = *(const u32x4*)(VT + (long)(c >> 3) * ldv + kt_lo * 64 + (c & 7) * 8); }
  const int qpos0 = q0 + wid * 16 + lr;
  for (int kt = kt_lo; kt < kt_hi; ++kt) {
    __syncthreads();
#pragma unroll
    for (int i = 0; i < KCH; ++i) {
      const int c = tid + 256 * i, row = c / KCPR, ch = c % KCPR;
      const int fsw = (KC > 64) ? (row & 15) : ((row >> 1) & 7);
      *(u32x4*)&Ks[row * KST + ((ch ^ fsw) & KXM) * 8] = rk[i];
    }
#pragma unroll
    for (int i = 0; i < VCH; ++i) { const int c = tid + 256 * i; *(u32x4*)&Vs[(c >> 3) * 72 + (c & 7) * 8] = rv[i]; }
    __syncthreads();
    if (kt + 1 < kt_hi) {
#pragma unroll
      for (int i = 0; i < KCH; ++i) { const int c = tid + 256 * i; rk[i] = *(const u32x4*)(Kb + (long)((kt + 1) * 64 + c / KCPR) * ldk + (c % KCPR) * 8); }
#pragma unroll
      for (int i = 0; i < VCH; ++i) { const int c = tid + 256 * i; rv[i] = *(const u32x4*)(VT + (long)(c >> 3) * ldv + (kt + 1) * 64 + (c & 7) * 8); }
    }
    const bool need_mask = (kt * 64 + 63 > q0) || (kt * 64 < q0 + (QT * 64 - 1) - win);
    bf16x8 pb[QT][NMAP][2];
#pragma unroll
    for (int m = 0; m < NMAP; ++m) {
      f32x4 s[QT][4];
#pragma unroll
      for (int qi = 0; qi < QT; ++qi)
#pragma unroll
        for (int t4 = 0; t4 < 4; ++t4) s[qi][t4] = (f32x4){0.f, 0.f, 0.f, 0.f};
#pragma unroll
      for (int ks = 0; ks < NKS; ++ks) {
        const int ch = (m * DQK + ks * 32) / 8 + g;
        const int fsw = (KC > 64) ? lr : ((lr >> 1) & 7);
        bf16x8 kf[4];
#pragma unroll
        for (int t4 = 0; t4 < 4; ++t4) kf[t4] = ldfrag(&Ks[(t4 * 16 + lr) * KST + ((ch ^ fsw) & KXM) * 8]);
        __builtin_amdgcn_sched_barrier(0);
#pragma unroll
        for (int qi = 0; qi < QT; ++qi)
#pragma unroll
          for (int t4 = 0; t4 < 4; ++t4) s[qi][t4] = mma(kf[t4], qf[qi][m][ks], s[qi][t4]);
        __builtin_amdgcn_sched_barrier(0);
      }
#pragma unroll
      for (int qi = 0; qi < QT; ++qi) {
        const int qpos = qpos0 + qi * 64;
        float mx = -1e30f;
#pragma unroll
        for (int t4 = 0; t4 < 4; ++t4)
#pragma unroll
          for (int r = 0; r < 4; ++r) {
            float v = s[qi][t4][r];
            if (need_mask) { const int kpos = kt * 64 + t4 * 16 + g * 4 + r; if (kpos > qpos || kpos < qpos - win) v = -1e30f; }
            s[qi][t4][r] = v; mx = fmaxf(mx, v);
          }
        mx = fmaxf(mx, __shfl_xor(mx, 16)); mx = fmaxf(mx, __shfl_xor(mx, 32));
        const float mnew = fmaxf(mrun[qi][m], mx * scale2);
        const float alpha = ex2(mrun[qi][m] - mnew);
        mrun[qi][m] = mnew;
        const float msafe = (mnew < -1e29f) ? 0.f : mnew;
        float ls = 0.f;
#pragma unroll
        for (int t4 = 0; t4 < 4; ++t4)
#pragma unroll
          for (int r = 0; r < 4; ++r) { const float pv = ex2(__builtin_fmaf(s[qi][t4][r], scale2, -msafe)); s[qi][t4][r] = pv; ls += pv; }
        lrun[qi][m] = lrun[qi][m] * alpha + ls;
        if (__builtin_amdgcn_ballot_w64(alpha != 1.f) != 0ull) {
#pragma unroll
          for (int dt = 0; dt < NDT; ++dt) O[qi][m][dt] *= alpha;
        }
#pragma unroll
        for (int kk = 0; kk < 2; ++kk) {
          u32x4 u;
          u.x = pk2(s[qi][2 * kk][0], s[qi][2 * kk][1]); u.y = pk2(s[qi][2 * kk][2], s[qi][2 * kk][3]);
          u.z = pk2(s[qi][2 * kk + 1][0], s[qi][2 * kk + 1][1]); u.w = pk2(s[qi][2 * kk + 1][2], s[qi][2 * kk + 1][3]);
          pb[qi][m][kk] = __builtin_bit_cast(bf16x8, u);
        }
      }
      __builtin_amdgcn_sched_barrier(0);
    }
    {
#pragma unroll
      for (int dg = 0; dg < NDT / 4; ++dg)
#pragma unroll
        for (int kk = 0; kk < 2; ++kk) {
          bf16x8 va[4];
#pragma unroll
          for (int j4 = 0; j4 < 4; ++j4) {
            const int dt = dg * 4 + j4;
            const u32x2 v0 = *(const u32x2*)&Vs[(dt * 16 + lr) * 72 + (2 * kk) * 16 + g * 4];
            const u32x2 v1 = *(const u32x2*)&Vs[(dt * 16 + lr) * 72 + (2 * kk + 1) * 16 + g * 4];
            u32x4 u; u.x = v0.x; u.y = v0.y; u.z = v1.x; u.w = v1.y;
            va[j4] = __builtin_bit_cast(bf16x8, u);
          }
          __builtin_amdgcn_sched_barrier(0);
#pragma unroll
          for (int m = 0; m < NMAP; ++m)
#pragma unroll
            for (int qi = 0; qi < QT; ++qi)
#pragma unroll
              for (int j4 = 0; j4 < 4; ++j4) O[qi][m][dg * 4 + j4] = mma(va[j4], pb[qi][m][kk], O[qi][m][dg * 4 + j4]);
          __builtin_amdgcn_sched_barrier(0);
        }
    }
  }
#pragma unroll
  for (int qi = 0; qi < QT; ++qi)
#pragma unroll
    for (int m = 0; m < NMAP; ++m) { lrun[qi][m] += __shfl_xor(lrun[qi][m], 16); lrun[qi][m] += __shfl_xor(lrun[qi][m], 32); }
  __syncthreads();
}

DEVI void attnA_item(const P& p, int l, int a, char* smem) {
  const int tid = TID(), lane = tid & 63, wid = tid >> 6, g = lane >> 4, lr = lane & 15;
  const int qt = 31 - (a >> 5), bh = a & 31, bl = bh >> 2, hh = bh & 3;
  const bf16_t* Yb = p.f_Y() + (long)(bl * 2048) * LDY;
  f32x4 O1[1][2][8]; float mr1[1][2], ls1[1][2];
  auto& O = O1[0]; auto& mr = mr1[0]; auto& ls = ls1[0];
  attn_core<64, 2, 128, 1>(Yb + (long)(qt * 64) * LDY + YA_Q + hh * 128, LDY, Yb + YA_K + hh * 128, LDY,
                        p.f_AvT() + (long)((bl * 4 + hh) * 128) * 2048, 2048, 0, qt + 1, qt * 64, 1 << 30, 0.125f * LOG2E, O1, mr1, ls1,
                        (bf16_t*)smem);
  (void)mr;
  const float lam = p.f_lam()[l];
  const float lam_init = 0.8f - 0.6f * __expf(-0.3f * (float)l);
  const float i1 = 1.f / ls[0], i2 = lam / ls[1];
  float ss = 0.f;
#pragma unroll
  for (int dt = 0; dt < 8; ++dt)
#pragma unroll
    for (int r = 0; r < 4; ++r) { const float o = O[0][dt][r] * i1 - O[1][dt][r] * i2; O[0][dt][r] = o; ss += o * o; }
  ss += __shfl_xor(ss, 16); ss += __shfl_xor(ss, 32);
  const float rn = rsqrtf(ss * (1.f / 128.f) + EPS) * (1.f - lam_init);
  const int tokl = bl * 2048 + qt * 64 + wid * 16 + lr;
#pragma unroll
  for (int dt = 0; dt < 8; ++dt) {
    const int d = dt * 16 + g * 4;
    const float4 gn = *(const float4*)(p.subln_g + l * 128 + d);
    const u32x2 z = *(const u32x2*)(p.f_Y() + (long)tokl * LDY + YZ + hh * 128 + d);
    u32x2 o;
    o.x = pk2(O[0][dt][0] * rn * gn.x * siluf(lo2f(z.x)), O[0][dt][1] * rn * gn.y * siluf(hi2f(z.x)));
    o.y = pk2(O[0][dt][2] * rn * gn.z * siluf(lo2f(z.y)), O[0][dt][3] * rn * gn.w * siluf(hi2f(z.y)));
    *(u32x2*)(p.f_br() + (long)tokl * 2048 + hh * 128 + d) = o;
  }
}

DEVI void attnC_item(const P& p, int a, char* smem) {
  const int tid = TID(), lane = tid & 63, wid = tid >> 6, g = lane >> 4, lr = lane & 15;
  const int qt = 15 - (a >> 6), bh = a & 63, bl = bh >> 3, hh = bh & 7;
  f32x4 O[2][1][4]; float mr[2][1], ls[2][1];
  attn_core<96, 1, 64, 2>(p.f_Qc() + (long)(bl * 2048 + qt * 128) * 768 + hh * 96, 768, p.f_Kc() + (long)(bl * 2048) * 768 + hh * 96, 768,
                          p.f_CvT() + (long)((bl * 8 + hh) * 64) * 2048, 2048, 0, 2 * qt + 2, qt * 128, 1 << 30, 0.10206207261596575f * LOG2E, O, mr, ls,
                          (bf16_t*)smem);
#pragma unroll
  for (int qi = 0; qi < 2; ++qi) {
    const float il = 1.f / ls[qi][0];
    const int tokl = bl * 2048 + qt * 128 + qi * 64 + wid * 16 + lr;
#pragma unroll
    for (int dt = 0; dt < 4; ++dt) {
      const int d = dt * 16 + g * 4;
      const u32x2 z = *(const u32x2*)(p.f_Y() + (long)tokl * LDY + YZ + 1024 + hh * 64 + d);
      u32x2 o;
      o.x = pk2(O[qi][0][dt][0] * il * siluf(lo2f(z.x)), O[qi][0][dt][1] * il * siluf(hi2f(z.x)));
      o.y = pk2(O[qi][0][dt][2] * il * siluf(lo2f(z.y)), O[qi][0][dt][3] * il * siluf(hi2f(z.y)));
      *(u32x2*)(p.f_br() + (long)tokl * 2048 + 1024 + hh * 64 + d) = o;
    }
  }
}

DEVI void attnD_item(const P& p, int a, char* smem) {
  const int tid = TID(), lane = tid & 63, wid = tid >> 6, g = lane >> 4, lr = lane & 15;
  const int qt = a & 15, rest = a >> 4, hh = rest & 7, bl = (rest >> 3) & 7, gi = rest >> 6;
  const int dl = gi == 0 ? 1 : (gi == 1 ? 4 : 16), L = 2048 / dl;
  const int q0 = qt * 128, ss = (q0 / L) * L;
  const int lo = (q0 - 128 > ss) ? (q0 - 128) : ss;
  const bf16_t* Yb = p.f_Y() + (long)(bl * 2048) * LDY;
  f32x4 O[2][1][4]; float mr[2][1], ls[2][1];
  attn_core<64, 1, 64, 2>(Yb + (long)q0 * LDY + YD_Q + gi * 512 + hh * 64, LDY, Yb + YD_K + gi * 512 + hh * 64, LDY,
                          p.f_DvT() + (long)(((gi * 8 + bl) * 8 + hh) * 64) * 2048, 2048, lo >> 6, 2 * qt + 2, q0, 128, 0.125f * LOG2E, O, mr, ls,
                          (bf16_t*)smem);
#pragma unroll
  for (int qi = 0; qi < 2; ++qi) {
    const float il = 1.f / ls[qi][0];
    const int ppos = q0 + qi * 64 + wid * 16 + lr;
    const int s = (ppos % L) * dl + ppos / L;
    const long tokl = (long)gi * TG + bl * 2048 + s;
#pragma unroll
    for (int dt = 0; dt < 4; ++dt) {
      const int d = dt * 16 + g * 4;
      u32x2 o; o.x = pk2(O[qi][0][dt][0] * il, O[qi][0][dt][1] * il); o.y = pk2(O[qi][0][dt][2] * il, O[qi][0][dt][3] * il);
      *(u32x2*)(p.f_Do() + tokl * 512 + hh * 64 + d) = o;
    }
    if (g == 0) p.f_Dlse()[tokl * 8 + hh] = (mr[qi][0] + __log2f(ls[qi][0])) * LN2;
  }
}

DEVI void dcomb_item(const P& p, int item) {
  const int tid = TID();
  const int tokl = item * 128 + (tid >> 1), h0 = (tid & 1) * 4;
  for (int hq = 0; hq < 4; ++hq) {
    const int hh = h0 + hq;
    const float l0 = p.f_Dlse()[((long)0 * TG + tokl) * 8 + hh], l1 = p.f_Dlse()[((long)1 * TG + tokl) * 8 + hh], l2 = p.f_Dlse()[((long)2 * TG + tokl) * 8 + hh];
    const float mx = fmaxf(l0, fmaxf(l1, l2));
    float w0 = __expf(l0 - mx), w1 = __expf(l1 - mx), w2 = __expf(l2 - mx);
    const float inv = 1.f / (w0 + w1 + w2);
    w0 *= inv; w1 *= inv; w2 *= inv;
#pragma unroll
    for (int c = 0; c < 8; ++c) {
      const int col = hh * 64 + c * 8;
      const u32x4 a = *(const u32x4*)(p.f_Do() + ((long)0 * TG + tokl) * 512 + col);
      const u32x4 b = *(const u32x4*)(p.f_Do() + ((long)1 * TG + tokl) * 512 + col);
      const u32x4 cc = *(const u32x4*)(p.f_Do() + ((long)2 * TG + tokl) * 512 + col);
      const u32x4 z = *(const u32x4*)(p.f_Y() + (long)tokl * LDY + YZ + 1536 + col);
      u32x4 o;
      o.x = pk2((w0 * lo2f(a.x) + w1 * lo2f(b.x) + w2 * lo2f(cc.x)) * siluf(lo2f(z.x)), (w0 * hi2f(a.x) + w1 * hi2f(b.x) + w2 * hi2f(cc.x)) * siluf(hi2f(z.x)));
      o.y = pk2((w0 * lo2f(a.y) + w1 * lo2f(b.y) + w2 * lo2f(cc.y)) * siluf(lo2f(z.y)), (w0 * hi2f(a.y) + w1 * hi2f(b.y) + w2 * hi2f(cc.y)) * siluf(hi2f(z.y)));
      o.z = pk2((w0 * lo2f(a.z) + w1 * lo2f(b.z) + w2 * lo2f(cc.z)) * siluf(lo2f(z.z)), (w0 * hi2f(a.z) + w1 * hi2f(b.z) + w2 * hi2f(cc.z)) * siluf(hi2f(z.z)));
      o.w = pk2((w0 * lo2f(a.w) + w1 * lo2f(b.w) + w2 * lo2f(cc.w)) * siluf(lo2f(z.w)), (w0 * hi2f(a.w) + w1 * hi2f(b.w) + w2 * hi2f(cc.w)) * siluf(hi2f(z.w)));
      *(u32x4*)(p.f_br() + (long)tokl * 2048 + 1536 + col) = o;
    }
  }
}

DEVI void b1_item(const P& p, int l, int item, char* smem) {
  const int tid = TID(), lane = tid & 63, wid = tid >> 6, g = lane >> 4, lr = lane & 15;
  const int n = item & 31, hh = (item >> 5) & 3, bl = item >> 7;
  const int tok0 = bl * 2048 + n * 64;
  bf16_t* qs = (bf16_t*)smem;
  bf16_t* ks = qs + 64 * 136;
  bf16_t* vs = ks + 64 * 136;
  float* Lm = (float*)(smem + 52224);
  float* gcs = (float*)(smem + 52224 + 17408);
  float* betas = gcs + 64;
#pragma unroll 1
  for (int it = 0; it < 12; ++it) {
    const int part = it >> 2;
    const int wi = (it & 3) * 256 + tid;
    const int t = wi >> 4, c0 = (wi & 15) * 8;
    const int ccol = part * 512 + hh * 128 + c0;
    float acc[8];
#pragma unroll
    for (int e = 0; e < 8; ++e) acc[e] = 0.f;
#pragma unroll
    for (int jj = 0; jj < 4; ++jj) {
      const int sidx = n * 64 + t - 3 + jj;
      if (sidx >= 0) {
        const u32x4 xv = *(const u32x4*)(p.f_Y() + (long)(bl * 2048 + sidx) * LDY + YB_Q + ccol);
        const float4 wa = *(const float4*)(p.conv_b + ((long)l * 4 + jj) * 1536 + ccol);
        const float4 wb = *(const float4*)(p.conv_b + ((long)l * 4 + jj) * 1536 + ccol + 4);
        acc[0] += lo2f(xv.x) * wa.x; acc[1] += hi2f(xv.x) * wa.y; acc[2] += lo2f(xv.y) * wa.z; acc[3] += hi2f(xv.y) * wa.w;
        acc[4] += lo2f(xv.z) * wb.x; acc[5] += hi2f(xv.z) * wb.y; acc[6] += lo2f(xv.w) * wb.z; acc[7] += hi2f(xv.w) * wb.w;
      }
    }
    float ssq = 0.f;
#pragma unroll
    for (int e = 0; e < 8; ++e) { acc[e] = siluf(acc[e]); ssq += acc[e] * acc[e]; }
    float sc = 1.f;
    if (part < 2) {
      ssq += __shfl_xor(ssq, 1); ssq += __shfl_xor(ssq, 2); ssq += __shfl_xor(ssq, 4); ssq += __shfl_xor(ssq, 8);
      sc = rsqrtf(ssq + EPS);
      if (part == 0) sc *= 0.08838834764831845f;
    }
    u32x4 o;
    o.x = pk2(acc[0] * sc, acc[1] * sc); o.y = pk2(acc[2] * sc, acc[3] * sc); o.z = pk2(acc[4] * sc, acc[5] * sc); o.w = pk2(acc[6] * sc, acc[7] * sc);
    bf16_t* dst = (part == 0 ? qs : (part == 1 ? ks : vs)) + t * 136 + c0;
    *(u32x4*)dst = o;
  }
  if (wid == 0) {
    const bf16_t* yr = p.f_Y() + (long)(tok0 + lane) * LDY;
    const float bv = sigmf(bf2f(yr[YBETA + hh]));
    const float xd = bf2f(yr[YDECAY + hh]) + p.dt_bias[l * 4 + hh];
    const float sp = (xd > 20.f) ? xd : log1pf(__expf(xd));
    float gc = -__expf(p.a_log[l * 4 + hh]) * sp;
#pragma unroll
    for (int o = 1; o < 64; o <<= 1) { const float v = __shfl_up(gc, o); if (lane >= o) gc += v; }
    gcs[lane] = gc; betas[lane] = bv;
  }
  __syncthreads();
  {
    bf16_t* qkdst = p.f_QKm() + (long)item * 4096;
#pragma unroll
    for (int nt = 0; nt < 4; ++nt) {
      f32x4 akk = (f32x4){0.f, 0.f, 0.f, 0.f}, aqk = (f32x4){0.f, 0.f, 0.f, 0.f};
#pragma unroll
      for (int k4 = 0; k4 < 4; ++k4) {
        const bf16x8 bfr = ldfrag(&ks[(nt * 16 + lr) * 136 + k4 * 32 + g * 8]);
        akk = mma(ldfrag(&ks[(wid * 16 + lr) * 136 + k4 * 32 + g * 8]), bfr, akk);
        aqk = mma(ldfrag(&qs[(wid * 16 + lr) * 136 + k4 * 32 + g * 8]), bfr, aqk);
      }
      const int jc = nt * 16 + lr;
      const float gj = gcs[jc];
      float lt4[4];
#pragma unroll
      for (int r = 0; r < 4; ++r) {
        const int i = wid * 16 + g * 4 + r;
        const float dec = (i >= jc) ? __expf(gcs[i] - gj) : 0.f;
        lt4[r] = (i > jc) ? betas[i] * akk[r] * dec : 0.f;
        qkdst[i * 64 + jc] = f2bf(aqk[r] * dec);
      }
      *(float4*)&Lm[jc * 68 + wid * 16 + g * 4] = make_float4(lt4[0], lt4[1], lt4[2], lt4[3]);
    }
  }
  {
    const float glast = gcs[63];
#pragma unroll
    for (int it = 0; it < 4; ++it) {
      const int idx = tid + 256 * it;
      const int i = idx >> 4, c0 = (idx & 15) * 8;
      const float e = __expf(gcs[i]);
      const u32x4 u = *(const u32x4*)&qs[i * 136 + c0];
      u32x4 o;
      o.x = pk2(lo2f(u.x) * e, hi2f(u.x) * e); o.y = pk2(lo2f(u.y) * e, hi2f(u.y) * e); o.z = pk2(lo2f(u.z) * e, hi2f(u.z) * e); o.w = pk2(lo2f(u.w) * e, hi2f(u.w) * e);
      *(u32x4*)(p.f_QG() + (long)item * 8192 + i * 128 + c0) = o;
    }
    const int dk = tid >> 1, ih = (tid & 1) * 32;
    bf16_t* d = p.f_KGT() + (long)item * 8192 + dk * 64 + ih;
#pragma unroll
    for (int q = 0; q < 4; ++q) {
      float v[8];
#pragma unroll
      for (int e = 0; e < 8; ++e) { const int i = ih + q * 8 + e; v[e] = bf2f(ks[i * 136 + dk]) * __expf(glast - gcs[i]); }
      u32x4 o; o.x = pk2(v[0], v[1]); o.y = pk2(v[2], v[3]); o.z = pk2(v[4], v[5]); o.w = pk2(v[6], v[7]);
      *(u32x4*)(d + q * 8) = o;
    }
    if (tid == 0) p.f_dlast()[item] = __expf(glast);
  }
  __syncthreads();
  {
    const int which = wid >> 1, c = (wid & 1) * 64 + lane;
    const bf16_t* rsrc = which == 0 ? vs : ks;
    bf16_t* xdst = which == 0 ? vs : qs;
#pragma unroll 1
    for (int ib = 0; ib < 4; ++ib) {
      float a[16];
#pragma unroll
      for (int r = 0; r < 16; ++r) {
        const int i = ib * 16 + r;
        float rhs = bf2f(rsrc[i * 136 + c]) * betas[i];
        if (which) rhs *= __expf(gcs[i]);
        a[r] = rhs;
      }
#pragma unroll 1
      for (int j = 0; j < ib * 16; ++j) {
        const float xj = bf2f(xdst[j * 136 + c]);
        const float4 l0 = *(const float4*)&Lm[j * 68 + ib * 16 + 0], l1 = *(const float4*)&Lm[j * 68 + ib * 16 + 4];
        const float4 l2 = *(const float4*)&Lm[j * 68 + ib * 16 + 8], l3 = *(const float4*)&Lm[j * 68 + ib * 16 + 12];
        a[0] -= l0.x * xj; a[1] -= l0.y * xj; a[2] -= l0.z * xj; a[3] -= l0.w * xj;
        a[4] -= l1.x * xj; a[5] -= l1.y * xj; a[6] -= l1.z * xj; a[7] -= l1.w * xj;
        a[8] -= l2.x * xj; a[9] -= l2.y * xj; a[10] -= l2.z * xj; a[11] -= l2.w * xj;
        a[12] -= l3.x * xj; a[13] -= l3.y * xj; a[14] -= l3.z * xj; a[15] -= l3.w * xj;
      }
#pragma unroll
      for (int jj = 0; jj < 15; ++jj) {
        const float xj = a[jj];
        const float* lrow = &Lm[(ib * 16 + jj) * 68 + ib * 16];
#pragma unroll
        for (int r4 = 0; r4 < 4; ++r4) {
          if (r4 * 4 + 3 > jj) {
            const float4 lv = *(const float4*)(lrow + r4 * 4);
            if (r4 * 4 + 0 > jj) a[r4 * 4 + 0] -= lv.x * xj;
            if (r4 * 4 + 1 > jj) a[r4 * 4 + 1] -= lv.y * xj;
            if (r4 * 4 + 2 > jj) a[r4 * 4 + 2] -= lv.z * xj;
            if (r4 * 4 + 3 > jj) a[r4 * 4 + 3] -= lv.w * xj;
          }
        }
      }
#pragma unroll
      for (int r = 0; r < 16; ++r) xdst[(ib * 16 + r) * 136 + c] = f2bf(a[r]);
      if (which == 0) {
        bf16_t* d = p.f_UT() + (long)item * 8192 + c * 64 + ib * 16;
        u32x4 o0, o1;
        o0.x = pk2(a[0], a[1]); o0.y = pk2(a[2], a[3]); o0.z = pk2(a[4], a[5]); o0.w = pk2(a[6], a[7]);
        o1.x = pk2(a[8], a[9]); o1.y = pk2(a[10], a[11]); o1.z = pk2(a[12], a[13]); o1.w = pk2(a[14], a[15]);
        *(u32x4*)d = o0; *(u32x4*)(d + 8) = o1;
      } else {
        bf16_t* d = p.f_Wm() + (long)item * 8192 + (ib * 16) * 128 + c;
#pragma unroll
        for (int r = 0; r < 16; ++r) d[r * 128] = f2bf(a[r]);
      }
    }
  }
  __syncthreads();
}

DEVI void b2_item(const P& p, int l, int item, char* smem) {
  const int tid = TID(), lane = tid & 63, wid = tid >> 6, g = lane >> 4, lr = lane & 15;
  const int bl = item >> 2, hh = item & 3;
  bf16_t* ST = (bf16_t*)smem;
  bf16_t* VNT = ST + 128 * 144;
  for (int i = tid; i < 128 * 144 / 2; i += 256) ((unsigned*)ST)[i] = 0u;
  f32x4 Sacc[2][8];
#pragma unroll
  for (int a = 0; a < 2; ++a)
#pragma unroll
    for (int b = 0; b < 8; ++b) Sacc[a][b] = (f32x4){0.f, 0.f, 0.f, 0.f};
  bf16x8 fw[4], fq[4], fqk[2], fk[2][2];
  u32x2 fu[8], fz[8];
  float dlv;
  const long it0 = (long)item * 32;
  const long tok0 = (long)bl * 2048 + wid * 16 + lr;
  const bf16_t* zbase = p.f_Y() + YZ + 512 + hh * 128 + (long)bl * 2048 * LDY;
  const unsigned vW = (unsigned)((wid * 16 + lr) * 128 + g * 8) * 2u;
  const unsigned vU = (unsigned)(lr * 64 + wid * 16 + g * 4) * 2u;
  const unsigned vQ = (unsigned)((wid * 16 + lr) * 64 + g * 8) * 2u;
  const unsigned vK = (unsigned)((2 * wid * 16 + lr) * 64 + g * 8) * 2u;
  const unsigned vZ = (unsigned)((wid * 16 + lr) * LDY + g * 4) * 2u;
#define LDF(base, voff) (*(const bf16x8*)((const char*)(base) + (voff)))
#define LD2(base, voff) (*(const u32x2*)((const char*)(base) + (voff)))
  {
    const bf16_t* Wp = p.f_Wm() + it0 * 8192; const bf16_t* UTp = p.f_UT() + it0 * 8192; const bf16_t* QGp0 = p.f_QG() + it0 * 8192;
#pragma unroll
    for (int k4 = 0; k4 < 4; ++k4) { fw[k4] = LDF(Wp + k4 * 32, vW); fq[k4] = LDF(QGp0 + k4 * 32, vW); }
    {
      const bf16_t* QKp = p.f_QKm() + it0 * 4096; const bf16_t* KGp = p.f_KGT() + it0 * 8192;
#pragma unroll
      for (int k2 = 0; k2 < 2; ++k2) { fqk[k2] = LDF(QKp + k2 * 32, vQ); fk[0][k2] = LDF(KGp + k2 * 32, vK); fk[1][k2] = LDF(KGp + 16 * 64 + k2 * 32, vK); }
#pragma unroll
      for (int nt = 0; nt < 8; ++nt) fz[nt] = LD2(zbase + nt * 16, vZ);
      dlv = p.f_dlast()[it0];
    }
#pragma unroll
    for (int nt = 0; nt < 8; ++nt) fu[nt] = LD2(UTp + nt * 16 * 64, vU);
  }
#pragma unroll 1
  for (int n = 0; n < 32; ++n) {
    const int nn = (n + 1 < 32) ? n + 1 : 31;
    const long itn = it0 + nn;
    const long tokl = tok0 + n * 64;
    {
      const long it = it0 + n;
    }
    __syncthreads();
    f32x4 ao[8];
#pragma unroll
    for (int hf = 0; hf < 2; ++hf) {
      f32x4 av[4];
#pragma unroll
      for (int q4 = 0; q4 < 4; ++q4) av[q4] = (f32x4){0.f, 0.f, 0.f, 0.f};
#pragma unroll
      for (int k4 = 0; k4 < 4; ++k4) {
        bf16x8 fa[4];
#pragma unroll
        for (int q4 = 0; q4 < 4; ++q4) fa[q4] = ldfrag(&ST[((hf * 4 + q4) * 16 + lr) * 144 + k4 * 32 + g * 8]);
        __builtin_amdgcn_sched_barrier(0);
#pragma unroll
        for (int q4 = 0; q4 < 4; ++q4) av[q4] = mma(fw[k4], fa[q4], av[q4]);
        __builtin_amdgcn_sched_barrier(0);
      }
#pragma unroll
      for (int q4 = 0; q4 < 4; ++q4) {
        const int nt = hf * 4 + q4;
        u32x2 o; o.x = pk2(lo2f(fu[nt].x) - av[q4][0], hi2f(fu[nt].x) - av[q4][1]); o.y = pk2(lo2f(fu[nt].y) - av[q4][2], hi2f(fu[nt].y) - av[q4][3]);
        *(u32x2*)&VNT[(nt * 16 + lr) * 80 + wid * 16 + g * 4] = o;
      }
      __builtin_amdgcn_sched_barrier(0);
    }
    {
      const bf16_t* Wp = p.f_Wm() + itn * 8192; const bf16_t* UTp = p.f_UT() + itn * 8192;
#pragma unroll
      for (int k4 = 0; k4 < 4; ++k4) fw[k4] = LDF(Wp + k4 * 32, vW);
#pragma unroll
      for (int nt = 0; nt < 8; ++nt) fu[nt] = LD2(UTp + nt * 16 * 64, vU);
    }
#pragma unroll
    for (int nt = 0; nt < 8; ++nt) ao[nt] = (f32x4){0.f, 0.f, 0.f, 0.f};
#pragma unroll
    for (int gi = 0; gi < 8; ++gi) {
      bf16x8 fa[4];
#pragma unroll
      for (int q4 = 0; q4 < 4; ++q4) fa[q4] = ldfrag(&ST[(((gi & 1) * 4 + q4) * 16 + lr) * 144 + (gi >> 1) * 32 + g * 8]);
      __builtin_amdgcn_sched_barrier(0);
#pragma unroll
      for (int q4 = 0; q4 < 4; ++q4) ao[(gi & 1) * 4 + q4] = mma(fa[q4], fq[gi >> 1], ao[(gi & 1) * 4 + q4]);
      __builtin_amdgcn_sched_barrier(0);
    }
    __builtin_amdgcn_sched_barrier(0);
    {
      const bf16_t* QGp = p.f_QG() + itn * 8192;
#pragma unroll
      for (int k4 = 0; k4 < 4; ++k4) fq[k4] = LDF(QGp + k4 * 32, vW);
    }
    __syncthreads();
#pragma unroll
    for (int gi = 0; gi < 4; ++gi) {
      bf16x8 fa[4];
#pragma unroll
      for (int q4 = 0; q4 < 4; ++q4) fa[q4] = ldfrag(&VNT[(((gi & 1) * 4 + q4) * 16 + lr) * 80 + (gi >> 1) * 32 + g * 8]);
      __builtin_amdgcn_sched_barrier(0);
#pragma unroll
      for (int q4 = 0; q4 < 4; ++q4) ao[(gi & 1) * 4 + q4] = mma(fa[q4], fqk[gi >> 1], ao[(gi & 1) * 4 + q4]);
      __builtin_amdgcn_sched_barrier(0);
    }
    __builtin_amdgcn_sched_barrier(0);
    {
      const bf16_t* QKp = p.f_QKm() + itn * 4096;
#pragma unroll
      for (int k2 = 0; k2 < 2; ++k2) fqk[k2] = LDF(QKp + k2 * 32, vQ);
    }
    {
      float ss = 0.f;
#pragma unroll
      for (int nt = 0; nt < 8; ++nt)
#pragma unroll
        for (int r = 0; r < 4; ++r) ss += ao[nt][r] * ao[nt][r];
      ss += __shfl_xor(ss, 16); ss += __shfl_xor(ss, 32);
      const float rn = rsqrtf(ss * (1.f / 128.f) + EPS);
#pragma unroll
      for (int nt = 0; nt < 8; ++nt) {
        const int dv = nt * 16 + g * 4;
        const float4 gn = *(const float4*)(p.out_norm_b + l * 128 + dv);
        u32x2 o;
        o.x = pk2(ao[nt][0] * rn * gn.x * siluf(lo2f(fz[nt].x)), ao[nt][1] * rn * gn.y * siluf(hi2f(fz[nt].x)));
        o.y = pk2(ao[nt][2] * rn * gn.z * siluf(lo2f(fz[nt].y)), ao[nt][3] * rn * gn.w * siluf(hi2f(fz[nt].y)));
        *(u32x2*)(p.f_br() + tokl * 2048 + 512 + hh * 128 + dv) = o;
      }
    }
    __builtin_amdgcn_sched_barrier(0);
    {
#pragma unroll
      for (int nt = 0; nt < 8; ++nt) fz[nt] = LD2(zbase + (long)(nn * 64) * LDY + nt * 16, vZ);
    }
#pragma unroll
    for (int a = 0; a < 2; ++a)
#pragma unroll
      for (int nt = 0; nt < 8; ++nt) Sacc[a][nt] *= dlv;
#pragma unroll
    for (int gi = 0; gi < 4; ++gi) {
      bf16x8 fa[4];
#pragma unroll
      for (int q4 = 0; q4 < 4; ++q4) fa[q4] = ldfrag(&VNT[(((gi & 1) * 4 + q4) * 16 + lr) * 80 + (gi >> 1) * 32 + g * 8]);
      __builtin_amdgcn_sched_barrier(0);
#pragma unroll
      for (int q4 = 0; q4 < 4; ++q4) {
        const int nt = (gi & 1) * 4 + q4;
        Sacc[0][nt] = mma(fk[0][gi >> 1], fa[q4], Sacc[0][nt]); Sacc[1][nt] = mma(fk[1][gi >> 1], fa[q4], Sacc[1][nt]);
      }
      __builtin_amdgcn_sched_barrier(0);
    }
    __builtin_amdgcn_sched_barrier(0);
    {
      const bf16_t* KGp = p.f_KGT() + itn * 8192;
#pragma unroll
      for (int k2 = 0; k2 < 2; ++k2) { fk[0][k2] = LDF(KGp + k2 * 32, vK); fk[1][k2] = LDF(KGp + 16 * 64 + k2 * 32, vK); }
      dlv = p.f_dlast()[itn];
    }
#pragma unroll
    for (int a = 0; a < 2; ++a)
#pragma unroll
      for (int nt = 0; nt < 8; ++nt) {
        u32x2 o; o.x = pk2(Sacc[a][nt][0], Sacc[a][nt][1]); o.y = pk2(Sacc[a][nt][2], Sacc[a][nt][3]);
        *(u32x2*)&ST[(nt * 16 + lr) * 144 + (2 * wid + a) * 16 + g * 4] = o;
      }
  }
  __syncthreads();
}

DEVI void p4a_tile(const P& p, int l, int mtile, int ntile, char* smem) {
  const int tid = TID(), lane = tid & 63, wid = tid >> 6, g = lane >> 4, lr = lane & 15;
  const int wm = wid >> 1, wn = wid & 1;
  f32x4 tot[4][4];
  zero_acc(tot);
#pragma unroll 1
  for (int nb = 0; nb < 4; ++nb) {
    f32x4 acc[4][4];
    zero_acc(acc);
    gemm_core<true, 4>(p.f_br() + (long)(mtile * 128) * 2048 + nb * 512, 2048, p.f_wBrT() + ((long)((l * 4 + nb) * 1024) + ntile * 128) * 512, 512, 512, acc,
                       (bf16_t*)smem);
#pragma unroll
    for (int mt = 0; mt < 4; ++mt) {
      const long tokl = mtile * 128 + wm * 64 + mt * 16 + lr;
#pragma unroll
      for (int nt = 0; nt < 4; ++nt) {
        const int col = ntile * 128 + wn * 64 + nt * 16 + g * 4;
        const u32x2 gt = *(const u32x2*)(p.f_Y() + tokl * LDY + YMG + nb * 1024 + col);
        tot[mt][nt][0] += acc[mt][nt][0] * lo2f(gt.x); tot[mt][nt][1] += acc[mt][nt][1] * hi2f(gt.x);
        tot[mt][nt][2] += acc[mt][nt][2] * lo2f(gt.y); tot[mt][nt][3] += acc[mt][nt][3] * hi2f(gt.y);
      }
    }
  }
#pragma unroll
  for (int mt = 0; mt < 4; ++mt) {
    const long tokl = mtile * 128 + wm * 64 + mt * 16 + lr;
#pragma unroll
    for (int nt = 0; nt < 4; ++nt) {
      const int col = ntile * 128 + wn * 64 + nt * 16 + g * 4;
      u32x2 o; o.x = pk2(tot[mt][nt][0], tot[mt][nt][1]); o.y = pk2(tot[mt][nt][2], tot[mt][nt][3]);
      *(u32x2*)(p.f_merged() + tokl * 1024 + col) = o;
    }
  }
}

DEVI void p4b_tile(const P& p, int gg, int l, int mtile, int ntile, char* smem) {
  const int tid = TID(), lane = tid & 63, wid = tid >> 6, g = lane >> 4, lr = lane & 15;
  const int wm = wid >> 1, wn = wid & 1;
  f32x4 acc[4][4];
  zero_acc(acc);
  gemm_core<true>(p.f_merged() + (long)(mtile * 128) * 1024, 1024, p.f_wOutT() + ((long)l * 1024 + ntile * 128) * 1024, 1024, 1024, acc, (bf16_t*)smem);
  const float* xin = (l == 0) ? p.x : p.out;
  const int bglob = gg * NB + (mtile >> 4);
  const float* gate = p.f_mod() + (long)(l * 32 + bglob) * 3072 + 2048;
  const float alpha = 1.4142135623730951f;
#pragma unroll
  for (int mt = 0; mt < 4; ++mt) {
    const long tok = (long)gg * TG + mtile * 128 + wm * 64 + mt * 16 + lr;
#pragma unroll
    for (int nt = 0; nt < 4; ++nt) {
      const int col = ntile * 128 + wn * 64 + nt * 16 + g * 4;
      const float4 xv = *(const float4*)(xin + tok * 1024 + col);
      const float4 gv = *(const float4*)(gate + col);
      float4 o;
      o.x = alpha * xv.x + gv.x * acc[mt][nt][0]; o.y = alpha * xv.y + gv.y * acc[mt][nt][1];
      o.z = alpha * xv.z + gv.z * acc[mt][nt][2]; o.w = alpha * xv.w + gv.w * acc[mt][nt][3];
      *(float4*)(p.out + tok * 1024 + col) = o;
    }
  }
}

DEVI void p4c_row(const P& p, int gg, int l, long tok, int lane) {
  float* r = p.out + tok * 1024;
  float4 v[4];
#pragma unroll
  for (int i = 0; i < 4; ++i) v[i] = *(const float4*)(r + i * 256 + lane * 4);
  float mu, rstd;
  ln_stats(v, mu, rstd);
#pragma unroll
  for (int i = 0; i < 4; ++i) {
    const int col = i * 256 + lane * 4;
    const float4 gn = *(const float4*)(p.ln_g + l * 1024 + col), bb = *(const float4*)(p.ln_b + l * 1024 + col);
    v[i].x = (v[i].x - mu) * rstd * gn.x + bb.x; v[i].y = (v[i].y - mu) * rstd * gn.y + bb.y;
    v[i].z = (v[i].z - mu) * rstd * gn.z + bb.z; v[i].w = (v[i].w - mu) * rstd * gn.w + bb.w;
    *(float4*)(r + col) = v[i];
  }
  if (l == 0) {
    ln_stats(v, mu, rstd);
    const int b = (int)(tok >> 11);
    store_h(v, mu, rstd, p.f_mod() + (long)(1 * 32 + b) * 3072, p.f_h() + tok * LDH, lane);
  }
}


#define XB_TMO      128
#define XB_XCNT(j)  (256  + 64 * (j))
#define XB_XSUB(j)  (1280 + 64 * (j))
#define XB_XGEN(j)  (2304 + 64 * (j))
#define XB_TOP      3328
#define XB_TOPGEN   3392
#define XCD_BAR_WORDS 3456
#define XB_SPIN_CAP (1u << 22)
#define LAS __attribute__((address_space(3)))
DEVI unsigned xb_ld(unsigned* p) { return __hip_atomic_load(p, __ATOMIC_RELAXED, __HIP_MEMORY_SCOPE_AGENT); }
DEVI unsigned xb_add(unsigned* p, unsigned v) { return __hip_atomic_fetch_add(p, v, __ATOMIC_RELAXED, __HIP_MEMORY_SCOPE_AGENT); }
DEVI unsigned xb_xcc_id() { return (unsigned)__builtin_amdgcn_s_getreg((3 << 11) | 20) & 0xFu; }
#define XB_SPIN(cond, bar) do { unsigned _sp = 0; while (cond) { __builtin_amdgcn_s_sleep(1); \
    if ((++_sp & 255u) == 0u) { if (xb_ld(&(bar)[XB_TMO])) break; if (_sp > XB_SPIN_CAP) { atomicAdd(&(bar)[XB_TMO], 1u); break; } } } } while (0)
struct XcdBarrier { unsigned* bar; unsigned x; volatile LAS unsigned* st; };
DEVI XcdBarrier xcd_barrier_post(unsigned* bar, volatile LAS unsigned* st) {
  XcdBarrier b; b.bar = bar; b.x = xb_xcc_id(); b.st = st;
  if (threadIdx.x == 0) (void)xb_add(&bar[XB_XCNT(b.x)], 1u);
  return b;
}
DEVI void xcd_barrier_complete(unsigned* bar, unsigned x, unsigned& nloc, unsigned& nx) {
  const unsigned G = gridDim.x * gridDim.y * gridDim.z;
  unsigned sum, cnt, mine, sp = 0u;
  for (;;) {
    sum = 0u; cnt = 0u; mine = 0u;
#pragma unroll
    for (unsigned j = 0; j < 16; ++j) { const unsigned c = xb_ld(&bar[XB_XCNT(j)]); sum += c; cnt += (c > 0u) ? 1u : 0u; mine = (j == x) ? c : mine; }
    if (sum == G) break;
    __builtin_amdgcn_s_sleep(1);
    if ((++sp & 255u) == 0u) { if (xb_ld(&bar[XB_TMO])) break; if (sp > XB_SPIN_CAP) { atomicAdd(&bar[XB_TMO], 1u); break; } }
  }
  nloc = mine > 0u ? mine : 1u; nx = cnt > 0u ? cnt : 1u;
}
DEVI void xcd_barrier(const XcdBarrier& b) {
  asm volatile("s_waitcnt vmcnt(0)" ::: "memory");
  __syncthreads();
  if (threadIdx.x == 0) {
    unsigned* bar = b.bar;
    __builtin_amdgcn_s_waitcnt(0);
    unsigned nloc = b.st[0], nx = b.st[1];
    if (nloc == 0u) { xcd_barrier_complete(bar, b.x, nloc, nx); b.st[0] = nloc; b.st[1] = nx; }
    const unsigned old = xb_add(&bar[XB_XSUB(b.x)], 1u);
    const unsigned gen = old / nloc;
    if (old + 1u == (gen + 1u) * nloc) {
      __builtin_amdgcn_fence(__ATOMIC_RELEASE, "agent");
      asm volatile("s_waitcnt vmcnt(0)" ::: "memory");
      const unsigned og = xb_add(&bar[XB_TOP], 1u);
      const unsigned tg = og / nx;
      if (og + 1u == (tg + 1u) * nx) xb_add(&bar[XB_TOPGEN], 1u);
      else XB_SPIN(xb_ld(&bar[XB_TOPGEN]) == tg, bar);
      __builtin_amdgcn_fence(__ATOMIC_ACQUIRE, "agent");
      xb_add(&bar[XB_XGEN(b.x)], 1u);
      asm volatile("s_waitcnt vmcnt(0)" ::: "memory");
    } else {
      XB_SPIN(xb_ld(&bar[XB_XGEN(b.x)]) == gen, bar);
      __builtin_amdgcn_fence(__ATOMIC_ACQUIRE, "agent");
      asm volatile("s_waitcnt vmcnt(0)" ::: "memory");
    }
  }
  __syncthreads();
}

__shared__ __attribute__((aligned(16))) char g_smem[SMEM_BYTES];
__shared__ int s_item;

DEVI int next_item(int* ctr) {
  __syncthreads();
  if (threadIdx.x == 0) s_item = atomicAdd(ctr, 1);
  __syncthreads();
  return s_item;
}

struct P1Queue { int* c8; int x0; int d; };
DEVI bool p1_pop(P1Queue& qu, int& mt, int& nt) {
  while (qu.d < 8) {
    const int x = (qu.x0 + qu.d) & 7;
    const int qq = next_item(qu.c8 + x);
    if (qq < 1792) {
      const int st = qq >> 6, within = qq & 63;
      mt = 16 * x + (st & 3) * 4 + (within & 3);
      nt = (st >> 2) * 16 + (within >> 2);
      return true;
    }
    ++qu.d;
  }
  return false;
}

DEVI void p1_phase(const P& p, int gg, int l, int qidx, char* smem) {
  P1Queue qu; qu.c8 = p.f_ctr2() + qidx * 8; qu.x0 = (int)(xb_xcc_id() & 7u); qu.d = 0;
  int mt, nt;
  if (!p1_pop(qu, mt, nt)) return;
  P1Tile cur; p1_desc(p, gg, l, mt, nt, cur);
  const int tid = TID(), lrow = tid >> 3, lkc = (tid & 7) * 8;
  u32x4 ra0[4], rb0[4], ra1[4], rb1[4];
  {
    const unsigned voa = (unsigned)(lrow * (int)cur.rs + lkc) * 2u, vob = (unsigned)(lrow * LDW + lkc) * 2u;
#pragma unroll
    for (int i = 0; i < 4; ++i) {
      ra0[i] = *(const u32x4*)((const char*)(cur.A + (long)(32 * i) * cur.rs) + voa); rb0[i] = *(const u32x4*)((const char*)(cur.B + (long)(32 * i) * LDW) + vob);
    }
#pragma unroll
    for (int i = 0; i < 4; ++i) {
      ra1[i] = *(const u32x4*)((const char*)(cur.A + (long)(32 * i) * cur.rs + 64) + voa); rb1[i] = *(const u32x4*)((const char*)(cur.B + (long)(32 * i) * LDW + 64) + vob);
    }
  }
  for (;;) {
    P1Tile nxt = cur;
    const bool has_next = p1_pop(qu, mt, nt);
    if (has_next) p1_desc(p, gg, l, mt, nt, nxt);
    f32x4 acc[4][4];
    zero_acc(acc);
    if (cur.vt) gemm_stream<false>(cur.A, cur.rs, cur.B, nxt.A, nxt.rs, nxt.B, ra0, rb0, ra1, rb1, acc, (bf16_t*)smem);
    else gemm_stream<true>(cur.A, cur.rs, cur.B, nxt.A, nxt.rs, nxt.B, ra0, rb0, ra1, rb1, acc, (bf16_t*)smem);
    p1_epilogue(p, cur, acc, smem);
    if (!has_next) break;
    cur = nxt;
  }
}

template <int ph>
DEVI void run_pre(const P& p) {
  char* smem = g_smem;
  const int tid = TID(), lane = tid & 63, wid = tid >> 6;
  const int G = gridDim.x, bid = blockIdx.x;
  if (ph == 0) {
    constexpr int N0 = 96, N1 = N0 + 1, N2 = N1 + 256, N3 = N2 + 7168, N4 = N3 + 96, N5 = N4 + 64, N6 = N5 + 1024, N7 = N6 + 512;
    for (int it = bid; it < N7; it += G) {
      if (it < N0) mod_item(p, it, smem);
      else if (it < N1) {
        if (tid < 64) {
          for (int l = 0; l < 2; ++l) {
            const float s1 = wave_sum(p.lq1[l * 64 + lane] * p.lk1[l * 64 + lane]);
            const float s2 = wave_sum(p.lq2[l * 64 + lane] * p.lk2[l * 64 + lane]);
            const float lam_init = 0.8f - 0.6f * expf(-0.3f * (float)l);
            if (lane == 0) p.f_lam()[l] = expf(s1) - expf(s2) + lam_init;
          }
          for (int i = lane; i < 256; i += 64) { p.f_ctr()[i] = 0; p.f_ctr2()[i] = 0; }
        }
      } else if (it < N2) rope_item(p, it - N1);
      else if (it < N3) {
        const int q = it - N2, l = q / 3584, r = q % 3584, nt = r >> 4, kt = r & 15;
        tconv_tile<0>(p.w_in + (long)l * 1024 * 14248, 14248, p.f_wInT() + (long)l * LDY * LDW, LDW, nt * 64, kt * 64, nullptr, (float*)smem);
      } else if (it < N4) {
        const int q = it - N3, l = q / 48, r = q % 48, nt = r >> 2, kt = r & 3;
        tconv_tile<1>(p.w_uq + (long)l * 256 * 768, 768, p.f_wUqT() + (long)l * 768 * 256, 256, nt * 64, kt * 64, p.q_norm_c + l * 256, (float*)smem);
      } else if (it < N5) {
        const int q = it - N4, l = q / 32, r = q % 32, nt = r >> 1, kt = r & 1;
        tconv_tile<2>(p.w_ukv + (long)l * 128 * 1024, 1024, p.f_wUkvT() + (long)l * 1024 * 128, 128, nt * 64, kt * 64, p.kv_norm_c + l * 128, (float*)smem);
      } else if (it < N6) {
        const int q = it - N5, ln = q >> 7, r = q & 127, nt = r >> 3, kt = r & 7;
        tconv_tile<3>(p.w_br + (long)ln * 512 * 1024, 1024, p.f_wBrT() + (long)ln * 1024 * 512, 512, nt * 64, kt * 64, nullptr, (float*)smem);
      } else {
        const int q = it - N6, l = q >> 8, r = q & 255, nt = r >> 4, kt = r & 15;
        tconv_tile<3>(p.w_out + (long)l * 1024 * 1024, 1024, p.f_wOutT() + (long)l * 1024 * 1024, 1024, nt * 64, kt * 64, nullptr, (float*)smem);
      }
    }
    return;
  }
  if (ph == 1) {
    for (int it = bid; it < 65536 / 4; it += G) {
      const long tok = (long)it * 4 + wid;
      float4 v[4];
#pragma unroll
      for (int i = 0; i < 4; ++i) v[i] = *(const float4*)(p.x + tok * 1024 + i * 256 + lane * 4);
      float mu, rstd;
      ln_stats(v, mu, rstd);
      store_h(v, mu, rstd, p.f_mod() + (long)(tok >> 11) * 3072, p.f_h() + tok * LDH, lane);
    }
    return;
  }
}

DEVI void run_phase(const P& p, int ph) {
  char* smem = g_smem;
  const int tid = TID(), lane = tid & 63, wid = tid >> 6;
  const int G = gridDim.x, bid = blockIdx.x;
  const int q = ph - 2, gg = q / 12, l = (q % 12) / 6, k = q % 6;
  int* ctr = p.f_ctr() + (ph & 63);
  if (k == 0) {
    {
      const int x0 = (int)(xb_xcc_id() & 7u);
      int* c8 = p.f_ctr2() + (q / 6) * 8;
      for (int dd = 0; dd < 8; ++dd) {
        const int x = (x0 + dd) & 7;
        for (;;) {
          const int qq = next_item(c8 + x);
          if (qq >= 896) break;
          const int st = qq >> 6, within = qq & 63;
          P1Tile d;
          p1_desc2(p, gg, l, 16 * x + (st & 1) * 8 + (within & 7), (st >> 1) * 8 + (within >> 3), d);
          p1_tile2(p, d, smem);
        }
      }
    }
  } else if (k == 1) {
    constexpr int N0 = 1024, N1 = N0 + 1024, N2 = N1 + 768, N3 = N2 + 3072, N4 = N3 + 128;
    for (;;) {
      const int it = next_item(ctr);
      if (it >= N4) break;
      if (it < N0) b1_item(p, l, it, smem);
      else if (it < N1) { const int t = it - N0; p2_kvup_tile(p, gg, l, t >> 3, t & 7, smem); }
      else if (it < N2) { const int t = it - N1; p2_qup_tile(p, gg, l, t / 6, t % 6, smem); }
      else if (it < N3) attnD_item(p, it - N2, smem);
      else p2_kpe_item(p, gg, it - N3);
    }
  } else if (k == 2) {
    if (bid < (G >> 1))
    for (;;) {
      const int it = next_item(ctr);
      if (it >= 32) break;
      __builtin_amdgcn_s_setprio(3);
      b2_item(p, l, it, smem);
      __builtin_amdgcn_s_setprio(0);
    }
    {
      const int x0 = (int)(xb_xcc_id() & 7u);
      int* c8 = p.f_ctr2() + 64 + (q / 6) * 8;
      for (int dd = 0; dd < 8; ++dd) {
        const int x = (x0 + dd) & 7;
        for (;;) {
          const int i = next_item(c8 + x);
          if (i >= 256) break;
          if (i < 128) { const int bh = x + 8 * (i >> 5), qt = 31 - (i & 31); attnA_item(p, l, ((31 - qt) << 5) | bh, smem); }
          else { const int i2 = i - 128; const int bh = x + 8 * (i2 >> 4), qt = 15 - (i2 & 15); attnC_item(p, ((15 - qt) << 6) | bh, smem); }
        }
      }
    }
    for (;;) {
      const int it = next_item(ctr + 64);
      if (it >= 128) break;
      dcomb_item(p, it);
    }
  } else if (k == 3) {
    for (int it = bid; it < 1024; it += G) p4a_tile(p, l, it >> 3, it & 7, smem);
  } else if (k == 4) {
    for (int it = bid; it < 1024; it += G) p4b_tile(p, gg, l, it >> 3, it & 7, smem);
  } else {
    for (int it = bid; it < TG / 4; it += G) p4c_row(p, gg, l, (long)gg * TG + (long)it * 4 + wid, lane);
  }
}

__global__ void __launch_bounds__(256, 2) mega(P p, int ph_lo, int ph_hi) {
#if MULTI_LAUNCH
  run_phase(p, ph_lo);
#else
  cg::grid_group grid = cg::this_grid();
  __shared__ uint4 xb_words;
  if (threadIdx.x == 0) xb_words = make_uint4(0u, 0u, 0u, 0u);
  __syncthreads();
  XcdBarrier xb = xcd_barrier_post(p.f_bar(), (volatile LAS unsigned*)&xb_words);
  run_pre<0>(p); xcd_barrier(xb);
  run_pre<1>(p); xcd_barrier(xb);
  for (int ph = ph_lo + 2; ph < ph_hi; ++ph) {
    run_phase(p, ph);
    if (ph + 1 < ph_hi) {
      if (ph_hi < 0) grid.sync();
      if ((ph - 2) % 12 != 11) xcd_barrier(xb);
    }
  }
#endif
}

extern "C" void kernel_launch(void* const* d_in, const int* in_sizes, int n_in, void* d_out, int out_size, void* d_ws, size_t ws_size,
                              hipStream_t stream) {
  P p{};
  p.x = (const float*)d_in[0]; p.c = (const float*)d_in[1]; p.pos = (const int*)d_in[2];
  p.w_ada = (const float*)d_in[3]; p.b_ada = (const float*)d_in[4]; p.w_in = (const float*)d_in[5]; p.conv_b = (const float*)d_in[6];
  p.a_log = (const float*)d_in[7]; p.dt_bias = (const float*)d_in[8]; p.out_norm_b = (const float*)d_in[9];
  p.lq1 = (const float*)d_in[10]; p.lk1 = (const float*)d_in[11]; p.lq2 = (const float*)d_in[12]; p.lk2 = (const float*)d_in[13];
  p.subln_g = (const float*)d_in[14]; p.q_norm_c = (const float*)d_in[15]; p.w_uq = (const float*)d_in[16]; p.kv_norm_c = (const float*)d_in[17];
  p.w_ukv = (const float*)d_in[18]; p.w_br = (const float*)d_in[19]; p.w_out = (const float*)d_in[20]; p.ln_g = (const float*)d_in[21];
  p.ln_b = (const float*)d_in[22];
  p.out = (float*)d_out;
  p.ws = (char*)d_ws;
  if (WS_TOTAL > ws_size) { fprintf(stderr, "workspace too small: need %zu have %zu\n", (size_t)WS_TOTAL, ws_size); return; }
#if MULTI_LAUNCH
  for (int ph = 0; ph < NPHASE; ++ph) hipLaunchKernelGGL(mega, dim3(512), dim3(256), 0, stream, p, ph, ph + 1);
#else
  static int grid_blocks = 0;
  if (!grid_blocks) {
    int dev = 0, cus = 0, per_cu = 0;
    hipGetDevice(&dev);
    hipDeviceGetAttribute(&cus, hipDeviceAttributeMultiprocessorCount, dev);
    hipOccupancyMaxActiveBlocksPerMultiprocessor(&per_cu, mega, 256, 0);
    if (per_cu > 2) per_cu = 2;
    grid_blocks = cus * per_cu;
    grid_blocks &= ~7;
    if (grid_blocks < 8) grid_blocks = 8;
  }
  int lo = 0, hi = NPHASE;
  void* args[] = {&p, &lo, &hi};
  (void)hipMemsetAsync((char*)d_ws + WS_BAR_OFF, 0, XCD_BAR_WORDS * 4, stream);
  hipError_t e = hipLaunchCooperativeKernel((void*)mega, dim3(grid_blocks), dim3(256), args, 0, stream);
  if (e != hipSuccess) fprintf(stderr, "cooperative launch failed: %s (grid %d)\n", hipGetErrorString(e), grid_blocks);
#endif
}
```
